# Optimizing an MI355X kernel written in HIP

```python
import jax, jax.numpy as jnp
from jax import lax
import numpy as np

D_MODEL = 1024
BATCH = 8
SEQ = 4096
DEPTH = 2
DEC_BATCH = 16
DEC_SEQ = 64
PAST_LEN = 4096

CHUNK = 64
N_A_LAYERS = DEPTH // 2
N_B_LAYERS = DEPTH - N_A_LAYERS
A_HEADS = 4
A_DK = D_MODEL // 2 // A_HEADS
A_DV = D_MODEL // A_HEADS
A_QK = A_HEADS * A_DK
A_VW = A_HEADS * A_DV
A_GATE_RANK = 16
A_GATE_TAU = 16.0
A_IN = 2 * A_QK + 2 * A_VW + A_GATE_RANK
B_HEADS = 16
B_HEAD_DIM = D_MODEL // B_HEADS
Q_BLOCK = 128
D_FF = 2816
EPS = 1e-6
NEG_INF = -1e30

kernel_name = 'gla_fox_yoco_macaron_stream_step'


def rms_norm(x, g):
    xf = x.astype(jnp.float32)
    y = xf * lax.rsqrt(jnp.mean(xf * xf, axis=-1, keepdims=True) + EPS)
    return (y * g.astype(jnp.float32)).astype(x.dtype)


def swiglu_ffn(x, w_gu, w_down):
    g, u = jnp.split(x @ w_gu, 2, axis=-1)
    return (jax.nn.silu(g) * u) @ w_down


def gla_mixer(xn, w_in, w_g2, b_g, g_out, w_o, s0, chunk):
    bsz, t, _ = xn.shape
    n_c = t // chunk
    proj = xn @ w_in
    q = proj[..., :A_QK]
    k = proj[..., A_QK:2 * A_QK]
    v = proj[..., 2 * A_QK:2 * A_QK + A_VW]
    r = proj[..., 2 * A_QK + A_VW:2 * A_QK + 2 * A_VW]
    gl = proj[..., 2 * A_QK + 2 * A_VW:]
    log_a = jax.nn.log_sigmoid((gl @ w_g2 + b_g).astype(jnp.float32)) / A_GATE_TAU

    def to_chunks(z, d):
        return z.reshape(bsz, n_c, chunk, A_HEADS, d).transpose(0, 3, 1, 2, 4).astype(jnp.float32)

    qc = to_chunks(q, A_DK) * (A_DK ** -0.5)
    kc = to_chunks(k, A_DK)
    vc = to_chunks(v, A_DV)
    b = jnp.cumsum(to_chunks(log_a, A_DK), axis=3)
    b_last = b[:, :, :, -1:, :]
    q_e = qc * jnp.exp(b)
    k_e = kc * jnp.exp(-b)
    causal = jnp.tril(jnp.ones((chunk, chunk), dtype=bool))
    att = jnp.where(causal, jnp.einsum('bhcld,bhcmd->bhclm', q_e, k_e), 0.0)
    o_intra = jnp.einsum('bhclm,bhcme->bhcle', att, vc)
    decay_c = jnp.exp(b_last[:, :, :, 0, :])
    k_dec = kc * jnp.exp(b_last - b)

    def chunk_step(s, inp):
        dec, kd, vv, qq = inp
        o_inter = jnp.einsum('bhld,bhde->bhle', qq, s)
        s_new = dec[..., None] * s + jnp.einsum('bhld,bhle->bhde', kd, vv)
        return s_new, o_inter

    xs = (jnp.moveaxis(decay_c, 2, 0), jnp.moveaxis(k_dec, 2, 0), jnp.moveaxis(vc, 2, 0), jnp.moveaxis(q_e, 2, 0))
    s_fin, o_inter = lax.scan(chunk_step, s0.astype(jnp.float32), xs)
    o = o_intra + jnp.moveaxis(o_inter, 0, 2)
    o = o.transpose(0, 2, 3, 1, 4).reshape(bsz, t, A_HEADS, A_DV)
    o = rms_norm(o, g_out).astype(xn.dtype).reshape(bsz, t, A_VW) * jax.nn.silu(r)
    return o @ w_o, s_fin.astype(s0.dtype)


def shared_kv(h, kv_norm, w_kvf, b_f, g_k):
    bsz, t, _ = h.shape
    kvf = rms_norm(h, kv_norm) @ w_kvf
    k = rms_norm(kvf[..., :D_MODEL].reshape(bsz, t, B_HEADS, B_HEAD_DIM), g_k)
    v = kvf[..., D_MODEL:2 * D_MODEL].reshape(bsz, t, B_HEADS, B_HEAD_DIM)
    logf = jax.nn.log_sigmoid((kvf[..., 2 * D_MODEL:] + b_f).astype(jnp.float32)).astype(h.dtype)
    return k, v, logf


def fox_block(q_blk, cq_blk, qpos_blk, k, v, ck, kpos):
    s = jnp.einsum('bqhd,bkhd->bhqk', q_blk, k).astype(jnp.float32) * (B_HEAD_DIM ** -0.5)
    s = s + jnp.transpose(cq_blk, (0, 2, 1))[..., None] - jnp.transpose(ck, (0, 2, 1))[:, :, None, :]
    s = jnp.where(kpos[None, :] <= qpos_blk[:, None], s, NEG_INF)
    p = jax.nn.softmax(s, axis=-1).astype(v.dtype)
    return jnp.einsum('bhqk,bkhd->bqhd', p, v)


def fox_mixer(xn, k, v, logf, w_qg, g_q, w_o):
    bsz, t, _ = xn.shape
    n_k = k.shape[1]
    qg = xn @ w_qg
    q = rms_norm(qg[..., :D_MODEL].reshape(bsz, t, B_HEADS, B_HEAD_DIM), g_q)
    gate = qg[..., D_MODEL:]
    c = jnp.cumsum(logf.astype(jnp.float32), axis=1)
    cq = c[:, n_k - t:]
    kpos = jnp.arange(n_k)
    qpos = jnp.arange(n_k - t, n_k)
    blk = min(Q_BLOCK, t)
    n_blk = t // blk
    qb = q.reshape(bsz, n_blk, blk, B_HEADS, B_HEAD_DIM).transpose(1, 0, 2, 3, 4)
    cqb = cq.reshape(bsz, n_blk, blk, B_HEADS).transpose(1, 0, 2, 3)
    qposb = qpos.reshape(n_blk, blk)
    o = lax.map(lambda a: fox_block(a[0], a[1], a[2], k, v, c, kpos), (qb, cqb, qposb))
    o = o.transpose(1, 0, 2, 3, 4).reshape(bsz, t, D_MODEL)
    o = o * jax.nn.sigmoid(gate)
    return o @ w_o


def run_trunk(x, gla_s0, past_k, past_v, past_logf, chunk, ffn_norm, w_ffn_gu, w_ffn_down, mix_norm,
              a_w_in, a_w_g2, a_b_g, a_g_out, a_w_o, kv_norm, w_kvf, b_f, g_k, b_w_qg, b_g_q, b_w_o):
    h = x
    new_gla = []
    keys = None
    k_new = v_new = lf_new = None
    for layer in range(DEPTH):
        h = h + 0.5 * swiglu_ffn(rms_norm(h, ffn_norm[layer, 0]), w_ffn_gu[layer, 0], w_ffn_down[layer, 0])
        hn = rms_norm(h, mix_norm[layer])
        if layer < N_A_LAYERS:
            y, s_new = gla_mixer(hn, a_w_in[layer], a_w_g2[layer], a_b_g[layer], a_g_out[layer], a_w_o[layer],
                                 gla_s0[:, layer], chunk)
            new_gla.append(s_new)
        else:
            j = layer - N_A_LAYERS
            y = fox_mixer(hn, keys[0], keys[1], keys[2], b_w_qg[j], b_g_q[j], b_w_o[j])
        h = h + y
        h = h + 0.5 * swiglu_ffn(rms_norm(h, ffn_norm[layer, 1]), w_ffn_gu[layer, 1], w_ffn_down[layer, 1])
        if layer == N_A_LAYERS - 1:
            k_new, v_new, lf_new = shared_kv(h, kv_norm, w_kvf, b_f, g_k)
            if past_k is None:
                keys = (k_new, v_new, lf_new)
            else:
                keys = (jnp.concatenate([past_k, k_new], axis=1),
                        jnp.concatenate([past_v, v_new], axis=1),
                        jnp.concatenate([past_logf, lf_new], axis=1))
    return h, jnp.stack(new_gla, axis=1), k_new, v_new, lf_new


def setup_inputs(seed: int = 0) -> dict:
    key = jax.random.key(seed)
    ks = jax.random.split(key, 24)

    def nrm(k, shape, scale):
        return jax.random.normal(k, shape, jnp.float32) * scale

    def gain(k, shape):
        return 1.0 + 0.05 * jax.random.normal(k, shape, jnp.float32)

    return {
        'x_prompt': nrm(ks[0], (BATCH, SEQ, D_MODEL), 1.0),
        'x_sample': nrm(ks[1], (DEC_BATCH, DEC_SEQ, D_MODEL), 1.0),
        'state_gla': nrm(ks[2], (DEC_BATCH, N_A_LAYERS, A_HEADS, A_DK, A_DV), 1.0),
        'cache_k': nrm(ks[3], (DEC_BATCH, PAST_LEN, B_HEADS, B_HEAD_DIM), 1.0),
        'cache_v': nrm(ks[4], (DEC_BATCH, PAST_LEN, B_HEADS, B_HEAD_DIM), 1.0),
        'cache_logf': jax.nn.log_sigmoid(jax.random.uniform(ks[5], (DEC_BATCH, PAST_LEN, B_HEADS), jnp.float32, 1.0, 4.0)),
        'ffn_norm': gain(ks[6], (DEPTH, 2, D_MODEL)),
        'w_ffn_gu': nrm(ks[7], (DEPTH, 2, D_MODEL, 2 * D_FF), D_MODEL ** -0.5),
        'w_ffn_down': nrm(ks[8], (DEPTH, 2, D_FF, D_MODEL), D_FF ** -0.5),
        'mix_norm': gain(ks[9], (DEPTH, D_MODEL)),
        'a_w_in': nrm(ks[10], (N_A_LAYERS, D_MODEL, A_IN), D_MODEL ** -0.5),
        'a_w_g2': nrm(ks[11], (N_A_LAYERS, A_GATE_RANK, A_QK), A_GATE_RANK ** -0.5),
        'a_b_g': nrm(ks[12], (N_A_LAYERS, A_QK), 0.1),
        'a_g_out': gain(ks[13], (N_A_LAYERS, A_DV)),
        'a_w_o': nrm(ks[14], (N_A_LAYERS, A_VW, D_MODEL), A_VW ** -0.5),
        'kv_norm': gain(ks[15], (D_MODEL,)),
        'w_kvf': nrm(ks[16], (D_MODEL, 2 * D_MODEL + B_HEADS), D_MODEL ** -0.5),
        'b_f': jax.random.uniform(ks[17], (B_HEADS,), jnp.float32, 1.0, 4.0),
        'g_k': gain(ks[18], (B_HEAD_DIM,)),
        'b_w_qg': nrm(ks[19], (N_B_LAYERS, D_MODEL, 2 * D_MODEL), D_MODEL ** -0.5),
        'b_g_q': gain(ks[20], (N_B_LAYERS, B_HEAD_DIM)),
        'b_w_o': nrm(ks[21], (N_B_LAYERS, D_MODEL, D_MODEL), D_MODEL ** -0.5),
    }


def reference(x_prompt, x_sample, state_gla, cache_k, cache_v, cache_logf, ffn_norm, w_ffn_gu, w_ffn_down,
              mix_norm, a_w_in, a_w_g2, a_b_g, a_g_out, a_w_o, kv_norm, w_kvf, b_f, g_k, b_w_qg, b_g_q, b_w_o):
    s0_prompt = jnp.zeros((x_prompt.shape[0], N_A_LAYERS, A_HEADS, A_DK, A_DV), x_prompt.dtype)
    y_prompt, gla_prompt, k_prompt, v_prompt, lf_prompt = run_trunk(
        x_prompt, s0_prompt, None, None, None, CHUNK, ffn_norm, w_ffn_gu, w_ffn_down, mix_norm,
        a_w_in, a_w_g2, a_b_g, a_g_out, a_w_o, kv_norm, w_kvf, b_f, g_k, b_w_qg, b_g_q, b_w_o)
    y_sample, gla_sample, k_sample, v_sample, lf_sample = run_trunk(
        x_sample, state_gla, cache_k, cache_v, cache_logf, x_sample.shape[1], ffn_norm, w_ffn_gu, w_ffn_down,
        mix_norm, a_w_in, a_w_g2, a_b_g, a_g_out, a_w_o, kv_norm, w_kvf, b_f, g_k, b_w_qg, b_g_q, b_w_o)
    return (y_prompt, y_sample, gla_prompt, gla_sample, k_prompt, v_prompt, lf_prompt, k_sample, v_sample, lf_sample)
```

```cpp
#include <hip/hip_runtime.h>
#include <hip/hip_cooperative_groups.h>
#include <hip/hip_bf16.h>
#include <cstdio>
#include <cstdint>
#include <cmath>
namespace cg = cooperative_groups;
namespace K {
constexpr int D = 1024, MP = 32768, MS = 1024, M = MP + MS, FF = 2816, NGU = 5632, NIN = 3328, NIN_SRC = 3088, NKVF = 2304, NKVF_SRC = 2064, NQG = 2048, NCAT = NKVF + NGU;
constexpr int SEQ = 4096, PAST = 4096, SKR = 4352  ;
constexpr float EPS = 1e-6f, LOG2E = 1.4426950408889634f, LN2 = 0.6931471805599453f;
constexpr float C2 = 0.125f * 1.4426950408889634f;
constexpr size_t O_Y = 0, O_GLAP = 34603008, O_GLAS = 35651584, O_KP = 37748736, O_VP = 71303168, O_LFP = 104857600, O_KS = 105381888, O_VS = 106430464, O_LFS = 107479040, O_TOTAL = 107495424;
}

__device__ __forceinline__ int lane_id_() { unsigned z = 0u; asm volatile("" : "+v"(z)); return (int)__builtin_amdgcn_mbcnt_hi(~0u, __builtin_amdgcn_mbcnt_lo(~0u, z)); }

namespace pg8 {
#define PG8_LAS __attribute__((address_space(3)))
typedef unsigned short bf16_t;
typedef short bf16x8 __attribute__((ext_vector_type(8)));
typedef float f32x4 __attribute__((ext_vector_type(4)));
typedef unsigned u32x4 __attribute__((ext_vector_type(4)));
constexpr int BM = 256, BK = 64, HALF = 128, HTB = HALF * BK * 2  , STAGE_BYTES = 8 * HTB, NXCD = 8, WGM = 8;

__host__ __device__ __forceinline__ int lds_byte(int r, int c) { const int st = (r >> 4) * 2 + (c >> 5), rr = r & 15, cc = c & 31, ob = rr * 64 + cc * 2; return st * 1024 + (ob ^ (((ob >> 9) & 1) << 5)); }
__host__ __device__ __forceinline__ void stage_rc(int b, int& R, int& C) { const int st = b / 1024, sb = b % 1024, swz = sb ^ (((sb >> 9) & 1) << 5); R = (st >> 1) * 16 + swz / 64; C = (st & 1) * 32 + (swz % 64) / 2; }
__host__ __device__ __forceinline__ int perm32(int rho) { const int n = rho >> 4, i = rho & 15; return 8 * (i >> 2) + 4 * n + (i & 3); }

struct Unit { int pm, pn, ks; };
struct Gemm { const bf16_t* A; const bf16_t* Bt; int M, N, K, ld; };

struct StaticOrder {
    int nM, nN, nwg, G, c;
    __host__ __device__ void init(int M, int N, int G_, int c_) { nM = M / BM; nN = N / BM; nwg = nM * nN; G = G_; c = c_; }
    __host__ __device__ bool next(int i, Unit& u) const {
        const long L = (long)i * G + c; if (L >= nwg) return false;
        int wgid = (int)L; { const int q = nwg / NXCD, r = nwg % NXCD, xcd = wgid % NXCD, off = wgid / NXCD; wgid = (xcd < r ? xcd * (q + 1) : r * (q + 1) + (xcd - r) * q) + off; }
        const int nig = WGM * nN, gid = wgid / nig, fm = gid * WGM, gsz = (nM - fm) < WGM ? (nM - fm) : WGM;
        u.pm = fm + ((wgid % nig) % gsz); u.pn = (wgid % nig) / gsz; u.ks = 0; return true;
    }
    __device__ __forceinline__ void a_ready(const Unit&) const {}
    __device__ __forceinline__ void done(const Unit&) const {}
};

__device__ __forceinline__ unsigned cvt_pk_bf16(float lo, float hi) { unsigned r; asm volatile("v_cvt_pk_bf16_f32 %0, %1, %2" : "=v"(r) : "v"(lo), "v"(hi)); return r; }
typedef float f32x2 __attribute__((ext_vector_type(2)));
struct SliceOrder {
    int pm0, nN, P, nun, G, c;
    __host__ __device__ void init(int pm0_, int nM, int nN_, int P_, int G_, int c_) { pm0 = pm0_; nN = nN_; P = P_; nun = nM * nN_ * P_; G = G_; c = c_; }
    __host__ __device__ bool next(int i, Unit& u) const { const long L = (long)i * G + c; if (L >= nun) return false; const int t = (int)L / P; u.ks = (int)L % P; u.pm = pm0 + t / nN; u.pn = t % nN; return true; }
    __device__ __forceinline__ void a_ready(const Unit&) const {}
    __device__ __forceinline__ void done(const Unit&) const {}
};

__device__ __forceinline__ float fast_sigmoid(float x) { return __builtin_amdgcn_rcpf(1.0f + __builtin_amdgcn_exp2f(-x * K::LOG2E)); }
__device__ __forceinline__ float logsigmoid_f(float z) { return fminf(z, 0.f) - K::LN2 * __builtin_amdgcn_logf(1.0f + __builtin_amdgcn_exp2f(-fabsf(z) * K::LOG2E)); }
typedef float f32x2v __attribute__((ext_vector_type(2))); typedef __bf16 bf16x2v __attribute__((ext_vector_type(2)));
__device__ __forceinline__ unsigned pkbf(float lo, float hi) { f32x2v v = {lo, hi}; bf16x2v b = __builtin_convertvector(v, bf16x2v); return __builtin_bit_cast(unsigned, b); }
__device__ __forceinline__ u32x4 pk8(const f32x4 a, const f32x4 b) { u32x4 w; w.x = pkbf(a[0], a[1]); w.y = pkbf(a[2], a[3]); w.z = pkbf(b[0], b[1]); w.w = pkbf(b[2], b[3]); return w; }
__device__ __forceinline__ float row_rstd(const float* psq, int row, int fq) {
    const f32x4 p = *(const f32x4*)(psq + (size_t)row * 16 + 4 * fq);
    float s = (p[0] + p[1]) + (p[2] + p[3]);
    s += __shfl_xor(s, 16); s += __shfl_xor(s, 32);
    return __builtin_amdgcn_rsqf(s * (1.0f / 1024.0f) + K::EPS);
}
#define ACC_T const f32x4 (&acc)[2][2][4][2]
struct CacheJob { const float* ck; const float* cv; bf16_t* ks; bf16_t* vs; int slot; };
constexpr long CJ_NVEC = (long)16 * K::PAST * 1024 / 8;
__device__ __forceinline__ void cj_load(const CacheJob& J, int uid, int tid, f32x4 (&a0)[4], f32x4 (&a1)[4]) {
#pragma unroll
    for (int j = 0; j < 4; ++j) { const long v = (long)uid * 2048 + j * 512 + tid; if (v < 2 * CJ_NVEC) { const bool isv = v >= CJ_NVEC; const float* src = (isv ? J.cv : J.ck) + (size_t)(isv ? v - CJ_NVEC : v) * 8;
            a0[j] = __builtin_nontemporal_load((const f32x4*)src); a1[j] = __builtin_nontemporal_load((const f32x4*)(src + 4)); } }
}
__device__ __forceinline__ void cj_store(const CacheJob& J, int uid, int tid, const f32x4 (&a0)[4], const f32x4 (&a1)[4]) {
#pragma unroll
    for (int j = 0; j < 4; ++j) { const long v = (long)uid * 2048 + j * 512 + tid; if (v < 2 * CJ_NVEC) { const bool isv = v >= CJ_NVEC; const size_t el = (size_t)(isv ? v - CJ_NVEC : v) * 8, b = el / ((size_t)K::PAST * 1024), rem = el - b * (size_t)K::PAST * 1024;
            *(u32x4*)((isv ? J.vs : J.ks) + b * (size_t)K::SKR * 1024 + rem) = pk8(a0[j], a1[j]); } }
}
__device__ __forceinline__ void epi_swiglu(ACC_T, int pm, int pnl, int wr, int wc, int fr, int fq, bf16_t* act, const float* psq, const CacheJob& J) {
    const int tid_ = (wr * 4 + wc) * 64 + fq * 16 + fr, uid_ = J.slot * 2904 + pm * 22 + pnl; f32x4 cj0[4], cj1[4];
    float rsv[2][4];
#pragma unroll
    for (int ai = 0; ai < 2; ++ai)
#pragma unroll
        for (int m = 0; m < 4; ++m) rsv[ai][m] = row_rstd(psq, pm * BM + ai * HALF + wr * 64 + m * 16 + fr, fq);
    asm volatile("" ::: "memory");
    if (J.slot >= 0) cj_load(J, uid_, tid_, cj0, cj1);
#pragma unroll
    for (int ai = 0; ai < 2; ++ai)
#pragma unroll
        for (int m = 0; m < 4; ++m) {
            const int row = pm * BM + ai * HALF + wr * 64 + m * 16 + fr; const float rs = rsv[ai][m];
            f32x4 o[2];
#pragma unroll
            for (int n = 0; n < 2; ++n) { const f32x4 g = acc[ai][0][m][n] * rs, u = acc[ai][1][m][n] * rs;
#pragma unroll
                for (int j = 0; j < 4; ++j) o[n][j] = g[j] * fast_sigmoid(g[j]) * u[j]; }
            __builtin_nontemporal_store(pk8(o[0], o[1]), (u32x4*)(act + (size_t)row * K::FF + pnl * 128 + wc * 32 + 8 * fq));
        }
    if (J.slot >= 0) cj_store(J, uid_, tid_, cj0, cj1);
}
struct EpiSwiGLU { static constexpr bool PERM = true, AFTER_DRAIN = false; bf16_t* act; const float* psq; CacheJob J;
    __device__ __forceinline__ void operator()(ACC_T, const Unit& u, int wr, int wc, int fr, int fq) const { epi_swiglu(acc, u.pm, u.pn, wr, wc, fr, fq, act, psq, J); } };
struct EpiResid { static constexpr bool PERM = true, AFTER_DRAIN = false;
    bf16_t* hb; float* psq; float scale; float* yout;
    __device__ __forceinline__ void operator()(ACC_T, const Unit& u, int wr, int wc, int fr, int fq) const {
#pragma unroll
        for (int ai = 0; ai < 2; ++ai)
#pragma unroll
            for (int m = 0; m < 4; ++m) {
                const int row = u.pm * BM + ai * HALF + wr * 64 + m * 16 + fr; const size_t off = (size_t)row * K::D + u.pn * BM + wc * 32 + 8 * fq; float ss = 0.f;
#pragma unroll
                for (int bj = 0; bj < 2; ++bj) {
                    const u32x4 hw = *(const u32x4*)(hb + off + bj * HALF);
                    f32x4 v0, v1;
                    v0[0] = __uint_as_float(hw.x << 16); v0[1] = __uint_as_float(hw.x & 0xffff0000u); v0[2] = __uint_as_float(hw.y << 16); v0[3] = __uint_as_float(hw.y & 0xffff0000u);
                    v1[0] = __uint_as_float(hw.z << 16); v1[1] = __uint_as_float(hw.z & 0xffff0000u); v1[2] = __uint_as_float(hw.w << 16); v1[3] = __uint_as_float(hw.w & 0xffff0000u);
                    v0 = v0 + acc[ai][bj][m][0] * scale; v1 = v1 + acc[ai][bj][m][1] * scale;
                    if (yout) { *(f32x4*)(yout + off + bj * HALF) = v0; *(f32x4*)(yout + off + bj * HALF + 4) = v1; }
                    else { ss += (v0[0] * v0[0] + v0[1] * v0[1]) + (v0[2] * v0[2] + v0[3] * v0[3]) + (v1[0] * v1[0] + v1[1] * v1[1]) + (v1[2] * v1[2] + v1[3] * v1[3]);
                        *(u32x4*)(hb + off + bj * HALF) = pk8(v0, v1); }
                }
                if (!yout) { ss += __shfl_xor(ss, 16); ss += __shfl_xor(ss, 32);
                    if (fq == 0) psq[(size_t)row * 16 + u.pn * 4 + wc] = ss; }
                asm volatile("" ::: "memory");
            }
    }
};
struct EpiInProj { static constexpr bool PERM = true, AFTER_DRAIN = false;
    bf16_t* q; bf16_t* k; bf16_t* v; bf16_t* rs_; float* gl; const float* psq;
    __device__ __forceinline__ void operator()(ACC_T, const Unit& u, int wr, int wc, int fr, int fq) const {
        const int pn = u.pn;
#pragma unroll
        for (int ai = 0; ai < 2; ++ai)
#pragma unroll
            for (int m = 0; m < 4; ++m) {
                const int row = u.pm * BM + ai * HALF + wr * 64 + m * 16 + fr; const float rs = row_rstd(psq, row, fq);
                const int c = wc * 32 + 8 * fq;
                if (pn < 4) { bf16_t* dst = (pn < 2 ? q : k) + (size_t)row * 512 + (pn & 1) * 256 + c; const float s = pn < 2 ? rs * 0.08838834764831845f : rs;
#pragma unroll
                    for (int bj = 0; bj < 2; ++bj) *(u32x4*)(dst + bj * HALF) = pk8(acc[ai][bj][m][0] * s, acc[ai][bj][m][1] * s);
                } else if (pn < 8) { bf16_t* dst = v + (size_t)row * 1024 + (pn - 4) * 256 + c;
#pragma unroll
                    for (int bj = 0; bj < 2; ++bj) *(u32x4*)(dst + bj * HALF) = pk8(acc[ai][bj][m][0] * rs, acc[ai][bj][m][1] * rs);
                } else if (pn < 12) { bf16_t* dst = rs_ + (size_t)row * 1024 + (pn - 8) * 256 + c;
#pragma unroll
                    for (int bj = 0; bj < 2; ++bj) { f32x4 a = acc[ai][bj][m][0] * rs, b = acc[ai][bj][m][1] * rs;
#pragma unroll
                        for (int j = 0; j < 4; ++j) { a[j] = a[j] * fast_sigmoid(a[j]); b[j] = b[j] * fast_sigmoid(b[j]); }
                        *(u32x4*)(dst + bj * HALF) = pk8(a, b); }
                } else { if (wc == 0 && fq < 2) { float* dst = gl + (size_t)row * 16 + 8 * fq; *(f32x4*)dst = acc[ai][0][m][0] * rs; *(f32x4*)(dst + 4) = acc[ai][0][m][1] * rs; } }
            }
    }
};
struct EpiCat { static constexpr bool PERM = true, AFTER_DRAIN = false;
    float* dout; bf16_t* kp; bf16_t* vp; bf16_t* ks; bf16_t* vs; const float* g_k; const float* b_f; const float* psq; bf16_t* act; CacheJob J;
    __device__ __forceinline__ void operator()(ACC_T, const Unit& u, int wr, int wc, int fr, int fq) const {
        const int pn = u.pn;
        if (pn >= 9) { epi_swiglu(acc, u.pm, pn - 9, wr, wc, fr, fq, act, psq, J); return; }
        const bool samp = u.pm >= K::MP / BM;
#pragma unroll
        for (int ai = 0; ai < 2; ++ai)
#pragma unroll
            for (int m = 0; m < 4; ++m) {
                const int row = u.pm * BM + ai * HALF + wr * 64 + m * 16 + fr; const float rs = row_rstd(psq, row, fq);
                if (pn < 8) {
                    const int head = (pn & 3) * 4 + wc; const bool isk = pn < 4;
                    f32x4 x[2][2]; float ss = 0.f;
#pragma unroll
                    for (int bj = 0; bj < 2; ++bj)
#pragma unroll
                        for (int n = 0; n < 2; ++n) { x[bj][n] = acc[ai][bj][m][n] * rs; ss += (x[bj][n][0] * x[bj][n][0] + x[bj][n][1] * x[bj][n][1]) + (x[bj][n][2] * x[bj][n][2] + x[bj][n][3] * x[bj][n][3]); }
                    ss += __shfl_xor(ss, 16); ss += __shfl_xor(ss, 32);
                    const float rk = isk ? __builtin_amdgcn_rsqf(ss * (1.0f / 64.0f) + K::EPS) : 1.0f;
                    float* fo; bf16_t* bo;
                    if (!samp) { fo = dout + (isk ? K::O_KP : K::O_VP) + (size_t)row * 1024; bo = (isk ? kp : vp) + (size_t)row * 1024; }
                    else { const int sr = row - K::MP; fo = dout + (isk ? K::O_KS : K::O_VS) + (size_t)sr * 1024; bo = (isk ? ks : vs) + ((size_t)(sr >> 6) * K::SKR + K::PAST + (sr & 63)) * 1024; }
#pragma unroll
                    for (int bj = 0; bj < 2; ++bj) { const int hc = 32 * bj + 8 * fq; f32x4 a = x[bj][0] * rk, b = x[bj][1] * rk;
                        if (isk) { a = a * *(const f32x4*)(g_k + hc); b = b * *(const f32x4*)(g_k + hc + 4); }
                        __builtin_nontemporal_store(a, (f32x4*)(fo + head * 64 + hc)); __builtin_nontemporal_store(b, (f32x4*)(fo + head * 64 + hc + 4)); *(u32x4*)(bo + head * 64 + hc) = pk8(a, b); }
                } else {
                    if (wc == 0 && fq < 2) { float* fo = samp ? dout + K::O_LFS + (size_t)(row - K::MP) * 16 : dout + K::O_LFP + (size_t)row * 16;
                        f32x4 a = acc[ai][0][m][0] * rs + *(const f32x4*)(b_f + 8 * fq), b = acc[ai][0][m][1] * rs + *(const f32x4*)(b_f + 8 * fq + 4);
#pragma unroll
                        for (int j = 0; j < 4; ++j) { a[j] = logsigmoid_f(a[j]); b[j] = logsigmoid_f(b[j]); }
                        *(f32x4*)(fo + 8 * fq) = a; *(f32x4*)(fo + 8 * fq + 4) = b; }
                }
            }
    }
};
struct EpiQG { static constexpr bool PERM = true, AFTER_DRAIN = false;
    bf16_t* qp; bf16_t* gate; const float* g_q; const float* psq;
    __device__ __forceinline__ void operator()(ACC_T, const Unit& u, int wr, int wc, int fr, int fq) const {
        const int pn = u.pn; const int head = (pn & 3) * 4 + wc; const bool isq = pn < 4;
#pragma unroll
        for (int ai = 0; ai < 2; ++ai)
#pragma unroll
            for (int m = 0; m < 4; ++m) {
                const int row = u.pm * BM + ai * HALF + wr * 64 + m * 16 + fr; const float rs = row_rstd(psq, row, fq);
                f32x4 x[2][2]; float ss = 0.f;
#pragma unroll
                for (int bj = 0; bj < 2; ++bj)
#pragma unroll
                    for (int n = 0; n < 2; ++n) { x[bj][n] = acc[ai][bj][m][n] * rs; ss += (x[bj][n][0] * x[bj][n][0] + x[bj][n][1] * x[bj][n][1]) + (x[bj][n][2] * x[bj][n][2] + x[bj][n][3] * x[bj][n][3]); }
                ss += __shfl_xor(ss, 16); ss += __shfl_xor(ss, 32);
                bf16_t* bo;
                bo = (isq ? qp : gate) + (size_t)row * 1024;
                const float rq = __builtin_amdgcn_rsqf(ss * (1.0f / 64.0f) + K::EPS) * K::C2;
#pragma unroll
                for (int bj = 0; bj < 2; ++bj) { const int hc = 32 * bj + 8 * fq; f32x4 a, b;
                    if (isq) { a = x[bj][0] * rq * *(const f32x4*)(g_q + hc); b = x[bj][1] * rq * *(const f32x4*)(g_q + hc + 4); }
                    else {
#pragma unroll
                        for (int j = 0; j < 4; ++j) { a[j] = fast_sigmoid(x[bj][0][j]); b[j] = fast_sigmoid(x[bj][1][j]); } }
                    *(u32x4*)(bo + head * 64 + hc) = pk8(a, b); }
            }
    }
};
struct EpiPartial { static constexpr bool PERM = true, AFTER_DRAIN = false; float* part; float scale;
    __device__ __forceinline__ void operator()(ACC_T, const Unit& u, int wr, int wc, int fr, int fq) const {
        float* base = part + (size_t)u.ks * (K::MS * 1024);
#pragma unroll
        for (int ai = 0; ai < 2; ++ai)
#pragma unroll
            for (int m = 0; m < 4; ++m) { const int row = u.pm * BM + ai * HALF + wr * 64 + m * 16 + fr - K::MP; const size_t off = (size_t)row * K::D + u.pn * BM + wc * 32 + 8 * fq;
#pragma unroll
                for (int bj = 0; bj < 2; ++bj) { *(f32x4*)(base + off + bj * HALF) = acc[ai][bj][m][0] * scale; *(f32x4*)(base + off + bj * HALF + 4) = acc[ai][bj][m][1] * scale; } }
    }
};
#undef ACC_T

template <class Epi, class Sched, bool ALIGN_EPI = false, bool SP2 = false>
__device__ __forceinline__ void gemm_phase(PG8_LAS unsigned char* lds, const Gemm g, const Sched& S, const Epi& E, const int wv) {
    const int lane = lane_id_(), wid = wv, tid = wv * 64 + lane, wr = wid >> 2, wc = wid & 3, fr = lane & 15, fq = lane >> 4;
    const int K = g.ld, nt = g.K / BK;
    unsigned voffA[2], voffB[2];
#pragma unroll
    for (int i = 0; i < 2; ++i) { int R, C; stage_rc(tid * 16 + i * 8192, R, C); const int Rb = Epi::PERM ? ((R & ~31) + perm32(R & 31)) : R;
        voffA[i] = (unsigned)(R * K + C) * 2u; voffB[i] = (unsigned)(Rb * K + C) * 2u; }
    const size_t kstep = (size_t)(BK * 2);
    const size_t hstep = (size_t)HALF * K * 2;
    const size_t tstep = 2 * hstep;
    const unsigned ldsw = (unsigned)wid * 1024u;
    const int aoff = lds_byte(wr * 64 + fr, fq * 8), boff = lds_byte(wc * 32 + fr, fq * 8);
#define PG8_SA(b, h) (((b) * 2 + (h)) * HTB)
#define PG8_SB(b, h) ((4 + (b) * 2 + (h)) * HTB)
#define PG8_STAGE(bufoff, gbase, voff) do { _Pragma("unroll") for (int _i = 0; _i < 2; ++_i) \
        __builtin_amdgcn_global_load_lds((const unsigned*)((const char*)(gbase) + (voff)[_i]), (PG8_LAS unsigned*)(lds + (bufoff) + ldsw + _i * 8192), 16, 0, 0); } while (0)
#define PG8_LDA(dst, b, h) do { _Pragma("unroll") for (int m = 0; m < 4; ++m) _Pragma("unroll") for (int k = 0; k < 2; ++k) dst[m][k] = *(const PG8_LAS bf16x8*)(lds + PG8_SA(b, h) + aoff + m * 2048 + k * 1024); } while (0)
#define PG8_LDB(dst, b, h) do { _Pragma("unroll") for (int n = 0; n < 2; ++n) _Pragma("unroll") for (int k = 0; k < 2; ++k) dst[n][k] = *(const PG8_LAS bf16x8*)(lds + PG8_SB(b, h) + boff + n * 2048 + k * 1024); } while (0)
#define PG8_MMA(ai, bj, At, Bt) do { __builtin_amdgcn_s_setprio(1); _Pragma("unroll") for (int m = 0; m < 4; ++m) _Pragma("unroll") for (int n = 0; n < 2; ++n) _Pragma("unroll") for (int k = 0; k < 2; ++k) \
        acc[ai][bj][m][n] = __builtin_amdgcn_mfma_f32_16x16x32_bf16(Bt[n][k], At[m][k], acc[ai][bj][m][n], 0, 0, 0); __builtin_amdgcn_s_setprio(0); } while (0)
#define PG8_WAIT_V(n) asm volatile("s_waitcnt vmcnt(" #n ")" ::: "memory")
#define PG8_WAIT_L(n) asm volatile("s_waitcnt lgkmcnt(" #n ")" ::: "memory")
#define PG8_BAR __builtin_amdgcn_s_barrier()
#define PG8_SCHED __builtin_amdgcn_sched_barrier(0)
    Unit cur, nxt; int ui = 0;
    if (!S.next(0, cur)) return;
    f32x4 acc[2][2][4][2];
#pragma unroll
    for (int a = 0; a < 2; ++a)
#pragma unroll
        for (int b = 0; b < 2; ++b)
#pragma unroll
            for (int m = 0; m < 4; ++m)
#pragma unroll
                for (int n = 0; n < 2; ++n) acc[a][b][m][n] = (f32x4){0.f, 0.f, 0.f, 0.f};
    bf16x8 At[4][2], B0[2][2], B1[2][2];
    const size_t sstep = (size_t)g.K * 2;
    const char* cA = (const char*)g.A + (size_t)cur.pm * tstep + (size_t)cur.ks * sstep; const char* cB = (const char*)g.Bt + (size_t)cur.pn * tstep + (size_t)cur.ks * sstep;
    S.a_ready(cur);
    if constexpr (SP2) {
        PG8_STAGE(PG8_SB(0, 0), cB, voffB); PG8_STAGE(PG8_SB(0, 1), cB + hstep, voffB); PG8_STAGE(PG8_SA(0, 0), cA, voffA); PG8_STAGE(PG8_SA(0, 1), cA + hstep, voffA);
        if (wr == 1) PG8_BAR;
        PG8_WAIT_V(2); PG8_BAR;
        PG8_STAGE(PG8_SB(1, 0), cB + kstep, voffB); PG8_STAGE(PG8_SA(1, 0), cA + kstep, voffA); PG8_STAGE(PG8_SB(1, 1), cB + hstep + kstep, voffB);
        PG8_WAIT_V(6); PG8_BAR;
    } else {
        PG8_STAGE(PG8_SB(0, 0), cB, voffB); PG8_STAGE(PG8_SA(0, 0), cA, voffA); PG8_STAGE(PG8_SB(0, 1), cB + hstep, voffB); PG8_STAGE(PG8_SA(0, 1), cA + hstep, voffA);
        if (wr == 1) PG8_BAR;
        PG8_WAIT_V(4); PG8_BAR;
        PG8_STAGE(PG8_SB(1, 0), cB + kstep, voffB); PG8_STAGE(PG8_SA(1, 0), cA + kstep, voffA); PG8_STAGE(PG8_SB(1, 1), cB + hstep + kstep, voffB);
        PG8_WAIT_V(6); PG8_BAR;
    }
    for (;;) {
        const bool has_next = S.next(ui + 1, nxt);
        const char* nA = has_next ? (const char*)g.A + (size_t)nxt.pm * tstep + (size_t)nxt.ks * sstep : cA; const char* nB = has_next ? (const char*)g.Bt + (size_t)nxt.pn * tstep + (size_t)nxt.ks * sstep : cB;
        for (int t = 0; t < nt; t += 2) {
            const bool last = (t == nt - 2);
            const char* a1 = cA + (size_t)(t + 1) * kstep;
            const char* a2 = last ? nA : cA + (size_t)(t + 2) * kstep; const char* b2 = last ? nB : cB + (size_t)(t + 2) * kstep;
            const char* a3 = a2 + kstep; const char* b3 = b2 + kstep;
            if (last && has_next) S.a_ready(nxt);
            if constexpr (SP2) {
            PG8_LDB(B0, 0, 0); PG8_LDB(B1, 0, 1); PG8_SCHED; PG8_LDA(At, 0, 0); PG8_STAGE(PG8_SA(1, 1), a1 + hstep, voffA);
            PG8_WAIT_V(8); PG8_WAIT_L(0); PG8_BAR; PG8_MMA(0, 0, At, B0); PG8_MMA(0, 1, At, B1); PG8_BAR; PG8_SCHED;
            PG8_LDA(At, 0, 1); PG8_STAGE(PG8_SB(0, 0), b2, voffB); PG8_STAGE(PG8_SB(0, 1), b2 + hstep, voffB); PG8_STAGE(PG8_SA(0, 0), a2, voffA);
            PG8_WAIT_V(8); PG8_WAIT_L(0); PG8_BAR; PG8_MMA(1, 0, At, B0); PG8_MMA(1, 1, At, B1); PG8_BAR; PG8_SCHED;
            PG8_LDB(B0, 1, 0); PG8_LDB(B1, 1, 1); PG8_SCHED; PG8_LDA(At, 1, 0); PG8_STAGE(PG8_SA(0, 1), a2 + hstep, voffA);
            PG8_WAIT_V(8); PG8_WAIT_L(0); PG8_BAR; PG8_MMA(0, 0, At, B0); PG8_MMA(0, 1, At, B1); PG8_BAR; PG8_SCHED;
            PG8_LDA(At, 1, 1); PG8_STAGE(PG8_SB(1, 0), b3, voffB); PG8_STAGE(PG8_SB(1, 1), b3 + hstep, voffB); PG8_STAGE(PG8_SA(1, 0), a3, voffA);
            PG8_WAIT_V(8); PG8_WAIT_L(0); PG8_BAR; PG8_MMA(1, 0, At, B0); PG8_MMA(1, 1, At, B1); PG8_BAR; PG8_SCHED;
            } else {
            PG8_LDB(B0, 0, 0); PG8_SCHED; PG8_LDA(At, 0, 0); PG8_STAGE(PG8_SA(1, 1), a1 + hstep, voffA);
            PG8_WAIT_L(8); PG8_BAR; PG8_WAIT_L(0); PG8_MMA(0, 0, At, B0); PG8_BAR; PG8_SCHED;
            PG8_LDB(B1, 0, 1); PG8_STAGE(PG8_SB(0, 0), b2, voffB);
            PG8_BAR; PG8_WAIT_L(0); PG8_MMA(0, 1, At, B1); PG8_BAR;
            PG8_LDA(At, 0, 1); PG8_STAGE(PG8_SA(0, 0), a2, voffA);
            PG8_BAR; PG8_WAIT_L(0); PG8_MMA(1, 0, At, B0); PG8_BAR; PG8_SCHED;
            PG8_STAGE(PG8_SB(0, 1), b2 + hstep, voffB);
            PG8_WAIT_V(6); PG8_BAR; PG8_MMA(1, 1, At, B1); PG8_BAR;
            PG8_LDB(B0, 1, 0); PG8_SCHED; PG8_LDA(At, 1, 0); PG8_STAGE(PG8_SA(0, 1), a2 + hstep, voffA);
            PG8_WAIT_L(8); PG8_BAR; PG8_WAIT_L(0); PG8_MMA(0, 0, At, B0); PG8_BAR; PG8_SCHED;
            PG8_LDB(B1, 1, 1); PG8_STAGE(PG8_SB(1, 0), b3, voffB);
            PG8_BAR; PG8_WAIT_L(0); PG8_MMA(0, 1, At, B1); PG8_BAR;
            PG8_LDA(At, 1, 1); PG8_STAGE(PG8_SA(1, 0), a3, voffA);
            PG8_BAR; PG8_WAIT_L(0); PG8_MMA(1, 0, At, B0); PG8_BAR; PG8_SCHED;
            PG8_STAGE(PG8_SB(1, 1), b3 + hstep, voffB);
            PG8_WAIT_V(6); PG8_BAR; PG8_MMA(1, 1, At, B1); PG8_BAR;
            }
        }
        if constexpr (ALIGN_EPI) { if (wr == 0) PG8_BAR; }
        if constexpr (!Epi::AFTER_DRAIN) { E(acc, cur, wr, wc, fr, fq); S.done(cur); }
        if (!has_next) break;
#pragma unroll
        for (int a = 0; a < 2; ++a)
#pragma unroll
            for (int b = 0; b < 2; ++b)
#pragma unroll
                for (int m = 0; m < 4; ++m)
#pragma unroll
                    for (int n = 0; n < 2; ++n) acc[a][b][m][n] = (f32x4){0.f, 0.f, 0.f, 0.f};
        cur = nxt; cA = nA; cB = nB; ++ui;
        if constexpr (ALIGN_EPI) { if (wr == 1) PG8_BAR; }
    }
    PG8_WAIT_V(0);
    if constexpr (!ALIGN_EPI) { if (wr == 0) PG8_BAR; }
    PG8_BAR;
    if constexpr (Epi::AFTER_DRAIN) { E.fused(acc, cur, wr, wc, fr, fq, lds, wid, lane); S.done(cur); }
#undef PG8_SA
#undef PG8_SB
#undef PG8_STAGE
#undef PG8_LDA
#undef PG8_LDB
#undef PG8_MMA
#undef PG8_WAIT_V
#undef PG8_WAIT_L
#undef PG8_BAR
#undef PG8_SCHED
}
}
#include <hip/hip_bf16.h>
#include <cmath>
namespace attn_body {
using bf16=__hip_bfloat16;
using bf16x8=__attribute__((ext_vector_type(8)))short;
using s16x4=__attribute__((ext_vector_type(4)))short;
using f32x16=__attribute__((ext_vector_type(16)))float;
using u32x4=__attribute__((ext_vector_type(4)))unsigned;
constexpr int BATCH=8,NHEAD=16,SEQ=4096,D=64,DM=NHEAD*D;
constexpr int NW=8,QBLK=32,QB=QBLK*NW,KVBLK=64,NQB=SEQ/QB;
constexpr int ATTN_PITCH=DM, ATTN_UNIT_ROWS=QB;
__device__ __forceinline__ int crow(int r,int hi){return (r&3)+8*(r>>2)+4*hi;}
#define SBAR() __builtin_amdgcn_sched_barrier(0)
__device__ __forceinline__ void cmask(f32x16&p0,f32x16&p1,int jb,int qrel,int hi){
  const float NEG=-INFINITY; int kb=64*jb+4*hi; asm volatile("":"+v"(kb)); asm volatile("":"+v"(qrel));
  #pragma unroll
  for(int r=0;r<16;++r){int kv=kb+(r&3)+8*(r>>2); if(kv>qrel)p0[r]=NEG; if(kv+32>qrel)p1[r]=NEG;}
}

constexpr int NSLOT=3, SLOTB=8192; constexpr long KX_DELTA=7l<<20;
constexpr int LDS_K=0, LDS_V=NSLOT*SLOTB, LDS_WS=2*NSLOT*SLOTB, LDS_OST=LDS_WS+NW*64*4, LDS_C=LDS_OST+NW*4096, LDS_R=LDS_C+4352*4, LDS_Q=LDS_R+512, LDS_BYTES=LDS_Q+NW*4096;
constexpr float C2=0.125f*1.4426950408889634f;
__device__ __forceinline__ void glds16(const void*gsrc,unsigned lds_dst){unsigned keep;
  asm volatile("s_mov_b32 %0, m0\n\ts_mov_b32 m0, %2\n\ts_nop 0\n\tglobal_load_lds_dwordx4 %1, off\n\ts_mov_b32 m0, %0":"=&s"(keep):"v"(gsrc),"s"(lds_dst):"memory");}
__device__ __forceinline__ float max3f(float a,float b,float c){float r;asm("v_max3_f32 %0, %1, %2, %3":"=v"(r):"v"(a),"v"(b),"v"(c));return r;}
__device__ __forceinline__ float max2f(float a,float b){float r;asm("v_max_f32_e32 %0, %1, %2":"=v"(r):"v"(a),"v"(b));return r;}
__device__ __forceinline__ float fadd_s(float a,float b){float r;asm("v_add_f32_e32 %0, %1, %2":"=v"(r):"v"(a),"v"(b));return r;}
__device__ __forceinline__ float fsub_s(float a,float b){float r;asm("v_sub_f32_e32 %0, %1, %2":"=v"(r):"v"(a),"v"(b));return r;}
typedef float f32x2_t __attribute__((ext_vector_type(2))); typedef __bf16 bf16x2_t __attribute__((ext_vector_type(2)));
__device__ __forceinline__ unsigned cvtpk_s(float lo,float hi){f32x2_t v={lo,hi};bf16x2_t b=__builtin_convertvector(v,bf16x2_t);return __builtin_bit_cast(unsigned,b);}
#define WAIT_BAR(N) asm volatile("s_waitcnt vmcnt(" #N ") lgkmcnt(0)\n\ts_barrier":::"memory")

typedef __attribute__((address_space(3))) const char* lds_cptr0;
__device__ __forceinline__ void qkt(f32x16&p0,f32x16&p1,const char*Kslot,const bf16x8*qr,int r32,int hi){
  const char*kb=Kslot+hi*1024+r32*16;
  #pragma unroll
  for(int d0=0;d0<4;++d0){
    const bf16x8 b0=*reinterpret_cast<const bf16x8*>(kb+d0*2048);
    const bf16x8 b1=*reinterpret_cast<const bf16x8*>(kb+d0*2048+512);
    const bf16x8 qd=qr[d0];
    p0=__builtin_amdgcn_mfma_f32_32x32x16_bf16(b0,qd,p0,0,0,0);p1=__builtin_amdgcn_mfma_f32_32x32x16_bf16(b1,qd,p1,0,0,0);}
}
typedef __attribute__((address_space(3))) const char* lds_cptr;
typedef short v4i16_t __attribute__((ext_vector_type(4)));
__device__ __forceinline__ void kload8(bf16x8*kf,lds_cptr kp){
  kf[0]=*(const __attribute__((address_space(3))) bf16x8*)(kp);      kf[1]=*(const __attribute__((address_space(3))) bf16x8*)(kp+512);
  kf[2]=*(const __attribute__((address_space(3))) bf16x8*)(kp+2048); kf[3]=*(const __attribute__((address_space(3))) bf16x8*)(kp+2560);
  kf[4]=*(const __attribute__((address_space(3))) bf16x8*)(kp+4096); kf[5]=*(const __attribute__((address_space(3))) bf16x8*)(kp+4608);
  kf[6]=*(const __attribute__((address_space(3))) bf16x8*)(kp+6144); kf[7]=*(const __attribute__((address_space(3))) bf16x8*)(kp+6656);
}
__device__ __forceinline__ void kload2(bf16x8*kf,lds_cptr kp,int j){ kf[2*j]=*(const __attribute__((address_space(3))) bf16x8*)(kp+j*2048); kf[2*j+1]=*(const __attribute__((address_space(3))) bf16x8*)(kp+j*2048+512); }
__device__ __forceinline__ s16x4 vtr(lds_cptr p){ return __builtin_bit_cast(s16x4,__builtin_amdgcn_ds_read_tr16_b64_v4i16((__attribute__((address_space(3))) v4i16_t*)p)); }
__device__ __forceinline__ float rowmax(const f32x16&p0,const f32x16&p1){
  float a=max3f(p0[0],p0[1],p1[0]),b=max3f(p0[2],p0[3],p1[1]);a=max3f(a,p1[2],p1[3]);
  #pragma unroll
  for(int r=4;r<16;r+=4){a=max3f(a,p0[r],p0[r+1]);b=max3f(b,p0[r+2],p0[r+3]);a=max3f(a,p1[r],p1[r+1]);b=max3f(b,p1[r+2],p1[r+3]);}
  const float m=max2f(a,b);
  auto rr=__builtin_amdgcn_permlane32_swap(__float_as_uint(m),__float_as_uint(m),false,false);
  return max2f(__uint_as_float(rr[0]),__uint_as_float(rr[1]));
}
__device__ __forceinline__ void pv(f32x16*o,int vb,bf16x8 pa0,bf16x8 pa1,bf16x8 pa2,bf16x8 pa3){
  #pragma unroll
  for(int d0=0;d0<2;++d0){s16x4 lo[4],hi[4];
    #pragma unroll
    for(int ks=0;ks<4;++ks){
      asm volatile("ds_read_b64_tr_b16 %0,%1 offset:%c2":"=&v"(lo[ks]):"v"(vb),"i"(d0*4096+ks*1024):"memory");
      asm volatile("ds_read_b64_tr_b16 %0,%1 offset:%c2":"=&v"(hi[ks]):"v"(vb),"i"(d0*4096+ks*1024+512):"memory");}
    asm volatile("s_waitcnt lgkmcnt(0)":::"memory");SBAR();
    #define PK(k) (bf16x8){lo[k][0],lo[k][1],lo[k][2],lo[k][3],hi[k][0],hi[k][1],hi[k][2],hi[k][3]}
    o[d0]=__builtin_amdgcn_mfma_f32_32x32x16_bf16(pa0,PK(0),o[d0],0,0,0);
    o[d0]=__builtin_amdgcn_mfma_f32_32x32x16_bf16(pa1,PK(1),o[d0],0,0,0);
    o[d0]=__builtin_amdgcn_mfma_f32_32x32x16_bf16(pa2,PK(2),o[d0],0,0,0);
    o[d0]=__builtin_amdgcn_mfma_f32_32x32x16_bf16(pa3,PK(3),o[d0],0,0,0);
    #undef PK
  }
}

#ifndef ATTN_STORE16
#define ATTN_STORE16(p,v) (*(u32x4*)(p)=(v))
#endif
template<int THRL> __device__ __forceinline__ void attn_unit(const bf16*Qu,const bf16*__restrict__ Kh,const bf16*__restrict__ Vh,const long dO,const long dG,const float*__restrict__ cneg,const int NT,const unsigned stmask,char*shm,const int wv){
  int lane_=lane_id_(); asm volatile("":"+v"(lane_)); const int lane=lane_,tid=wv*64+lane,r32=lane&31,hi=lane>>5; const int wid=wv; const bool act=((stmask>>wv)&1u)!=0u;
  const bf16*Qw=Qu+(long)(wid*QBLK)*DM;
  const unsigned lds0=(unsigned)(uintptr_t)shm;
  float*wsf=(float*)(shm+LDS_WS)+wid*64;
  const bf16*ksrc=Kh+(long)lane*DM+wid*8;
  const bf16*vsrc=Vh+(long)(16*(wid&3)+(lane>>2))*DM+(wid>>2)*32+(lane&3)*8;
  const unsigned kdst=lds0+LDS_K+wid*1024, vdst=lds0+LDS_V+wid*1024;
  #define DMA_K(t,slot) glds16(ksrc+(long)(t)*KVBLK*DM,(unsigned)__builtin_amdgcn_readfirstlane(kdst+(slot)))
  #define DMA_V(t,slot) glds16(vsrc+(long)(t)*KVBLK*DM,(unsigned)__builtin_amdgcn_readfirstlane(vdst+(slot)))
  const int vb0=(int)(lds0+LDS_V)+((lane>>4)&1)*32+(lane&3)*8+(4*hi+((lane&15)>>2))*64;
  const char*Kbase=shm+LDS_K; bf16x8 kf[8];
  const lds_cptr shm3=(lds_cptr)shm; const lds_cptr kp0=shm3+LDS_K+hi*1024+r32*16; const lds_cptr vp0=shm3+LDS_V+((lane>>4)&1)*32+(lane&3)*8+(4*hi+((lane&15)>>2))*64;
  typedef __attribute__((address_space(3))) float* lds_fptr; typedef float f32x4c __attribute__((ext_vector_type(4)));
  typedef __attribute__((address_space(3))) unsigned* lds_uptr;
  const lds_uptr kx3=(lds_uptr)(shm3+LDS_C);
  const lds_fptr rl3=(lds_fptr)(shm3+LDS_R);
  { int t0_=tid; asm volatile("":"+v"(t0_)); unsigned cv_[9]; const unsigned* kxg=(const unsigned*)((const char*)cneg+KX_DELTA);
    #pragma unroll
    for(int u_=0;u_<9;++u_){ const int i_=t0_+u_*NW*64; cv_[u_]=(i_<NT*64)?kxg[i_]:0u; }
    const float rt0_=(t0_<NT)?cneg[64*t0_]:0.f;
    #pragma unroll
    for(int u_=0;u_<9;++u_){ const int i_=t0_+u_*NW*64; if(i_<NT*64)kx3[i_]=cv_[u_]; }
    if(t0_<NT)rl3[t0_]=rt0_; }
  typedef short s16x4b __attribute__((ext_vector_type(4)));
  const unsigned hm_=hi?0u:0xffffffffu;
  s16x4b bxa0_,bxa1_,bxq_;
  typedef unsigned u32x2b __attribute__((ext_vector_type(2)));
  #define BIASPREP(t) do{ const float nd_=rl3[t]-mhat; const unsigned nh_=cvtpk_s(nd_,0.f)&0xffffu; const float ndh_=__uint_as_float(nh_<<16); const unsigned nl_=cvtpk_s(nd_-ndh_,0.f)&0xffffu; \
    const unsigned k0_=kx3[(t)*64+r32]&hm_, k1_=kx3[(t)*64+32+r32]&hm_, on_=0x3f803f80u&hm_; \
    bxa0_=__builtin_bit_cast(s16x4b,(u32x2b){k0_,on_}); bxa1_=__builtin_bit_cast(s16x4b,(u32x2b){k1_,on_}); bxq_=__builtin_bit_cast(s16x4b,(u32x2b){on_,(nh_|(nl_<<16))&hm_}); }while(0)
  #define BIASMF(C0,C1) do{ C0=__builtin_amdgcn_mfma_f32_32x32x8bf16_1k(bxa0_,bxq_,zero16,0,0,0); C1=__builtin_amdgcn_mfma_f32_32x32x8bf16_1k(bxa1_,bxq_,zero16,0,0,0); }while(0)
  if(!act){
    int sc_=0,sn_=SLOTB;
    #define ROTI() do{sc_=sn_;sn_=(sn_==(NSLOT-1)*SLOTB)?0:sn_+SLOTB;}while(0)
    #define ENDWI(tt) do{ if((tt)+3<NT){WAIT_BAR(2);} else if((tt)+2<NT){WAIT_BAR(1);} else {WAIT_BAR(0);} }while(0)
    DMA_K(0,0);DMA_V(0,0);DMA_K(1,SLOTB);DMA_K(2,2*SLOTB);
    WAIT_BAR(3); WAIT_BAR(0);
    DMA_K(3,0);DMA_V(1,SLOTB); ROTI(); WAIT_BAR(2);
    int t=1;
    for(;t+5<NT;t+=2){ DMA_K(t+3,sc_);DMA_V(t+1,sn_); WAIT_BAR(2); ROTI(); DMA_K(t+4,sc_);DMA_V(t+2,sn_); WAIT_BAR(2); ROTI(); }
    for(;t+1<NT;t+=2){ if(t+3<NT){DMA_K(t+3,sc_);} if(t+1<NT){DMA_V(t+1,sn_);} ENDWI(t); ROTI(); if(t+4<NT){DMA_K(t+4,sc_);} if(t+2<NT){DMA_V(t+2,sn_);} ENDWI(t+1); ROTI(); }
    asm volatile("s_waitcnt lgkmcnt(0)\n\ts_barrier":::"memory");
    #undef ROTI
    #undef ENDWI
    return;
  }
  DMA_K(0,0);DMA_V(0,0);DMA_K(1,SLOTB);
  bf16x8 qr_[4];
  #pragma unroll
  for(int d0=0;d0<4;++d0)qr_[d0]=*reinterpret_cast<const bf16x8*>(&Qw[(long)r32*DM+d0*16+hi*8]);
  #define QL(d) qr_[d]
  float mhat=cneg[(NT-4)*64+wid*QBLK+r32],l_reg=0.f;     f32x16 o[2];o[0]=f32x16{};o[1]=f32x16{};const f32x16 zero16=f32x16{};
  const int qrel=wid*QBLK+r32;
  #define CMASK(P0,P1,t) do{int jb_=(t)-(NT-4); if(jb_>=0)cmask(P0,P1,jb_,qrel,hi);}while(0)
  bool resc=false;
  #define START(P0,P1) do{ const float rm=rowmax(P0,P1); resc=false; \
    { const float dl=__builtin_fmaxf(rm,0.f); mhat=fadd_s(mhat,dl); \
      _Pragma("unroll") for(int r=0;r<16;++r){P0[r]=fsub_s(P0[r],dl);P1[r]=fsub_s(P1[r],dl);} \
 } \
    _Pragma("unroll") for(int r=0;r<16;++r)P0[r]=__builtin_amdgcn_exp2f(P0[r]); }while(0)
  #define RESC() do{ if(resc){ asm volatile("s_waitcnt lgkmcnt(0)":::"memory"); \
      _Pragma("unroll") for(int d_=0;d_<2;++d_) _Pragma("unroll") for(int r=0;r<16;++r)o[d_][r]*=wsf[crow(r,hi)]; } }while(0)
  f32x16 pA0,pA1,pB0,pB1;
  int sl_prev=0,sl_cur=0,sl_next=SLOTB;
  #define ROT() do{sl_prev=sl_cur;sl_cur=sl_next;sl_next=(sl_next==(NSLOT-1)*SLOTB)?0:sl_next+SLOTB;}while(0)
  DMA_K(2,2*SLOTB);
  WAIT_BAR(3);
  BIASPREP(0);BIASMF(pA0,pA1);qkt(pA0,pA1,Kbase,qr_,r32,hi);asm volatile("s_nop 15\n\ts_nop 7":"+v"(pA0),"+v"(pA1));CMASK(pA0,pA1,0);
  START(pA0,pA1);
  BIASPREP(1);
  _Pragma("unroll") for(int r=0;r<16;++r)pA1[r]=__builtin_amdgcn_exp2f(pA1[r]);
  WAIT_BAR(0);
  DMA_K(3,0);DMA_V(1,SLOTB);
  ROT();
  kload8(kf,kp0+sl_cur);
  WAIT_BAR(2);
  s16x4 vlo[8],vhi[8]; u32x4 pw0,pw1,pw2,pw3;
  #define PKW(P,B) cvtpk_s(P[B],P[B+1])
  #define PAF(k) __builtin_bit_cast(bf16x8,pw##k)
  #define VFR(i) (bf16x8){vlo[i][0],vlo[i][1],vlo[i][2],vlo[i][3],vhi[i][0],vhi[i][1],vhi[i][2],vhi[i][3]}
  #define PIN(x) asm volatile("":"+v"(x))
  #define MX3(a,b,c) __builtin_fmaxf(__builtin_fmaxf((a),(b)),(c))
  #define GAPA(MF,A0,A1,A2,A3,W0,W1,PW) do{ MF; sacc+=A0; sacc+=A1; sacc+=A2; sacc+=A3; PIN(sacc); W0; W1; PIN(PW); SBAR(); }while(0)
  #define EX(v) __builtin_amdgcn_exp2f(v)
  #define GAPB(MF,X,B) do{ MF; X[B]=EX(X[B]); X[B+1]=EX(X[B+1]); X[B+2]=EX(X[B+2]); X[B+3]=EX(X[B+3]); PIN(X); SBAR(); }while(0)
  #define VRD(i) do{ vlo[i]=vtr(vp_+(((i)>>2)*4096+((i)&3)*1024)); vhi[i]=vtr(vp_+(((i)>>2)*4096+((i)&3)*1024+512)); }while(0)
  #define KRD(G,j) do{ if(G){ kload2(kf,kp0+sl_next,j); SBAR(); } }while(0)
  #define STEP(C0,C1,P0,P1,t,GK,GV,GL) do{ SBAR(); \
    const lds_cptr vp_=vp0+sl_prev; \
    VRD(0); const bf16x8 q0_=QL(0); BIASMF(C0,C1); SBAR(); float sacc=(P0[0]+P0[1]); \
    GAPA(C0=__builtin_amdgcn_mfma_f32_32x32x16_bf16(kf[0],q0_,C0,0,0,0), P0[2],P0[3],P0[4],P0[5],     pw0[0]=PKW(P0,0), pw0[1]=PKW(P0,2), pw0); \
    VRD(4); const bf16x8 q1_=QL(1); SBAR(); GAPA(C1=__builtin_amdgcn_mfma_f32_32x32x16_bf16(kf[1],q0_,C1,0,0,0), P0[6],P0[7],P0[8],P0[9],     pw0[2]=PKW(P0,4), pw0[3]=PKW(P0,6), pw0); \
    VRD(1); SBAR(); GAPA(C0=__builtin_amdgcn_mfma_f32_32x32x16_bf16(kf[2],q1_,C0,0,0,0),   P0[10],P0[11],P0[12],P0[13], pw1[0]=PKW(P0,8), pw1[1]=PKW(P0,10), pw1); \
    VRD(5); const bf16x8 q2_=QL(2); SBAR(); GAPA(C1=__builtin_amdgcn_mfma_f32_32x32x16_bf16(kf[3],q1_,C1,0,0,0),   P0[14],P0[15],P1[0],P1[1],   pw1[2]=PKW(P0,12),pw1[3]=PKW(P0,14), pw1); \
    VRD(2); SBAR(); GAPA(C0=__builtin_amdgcn_mfma_f32_32x32x16_bf16(kf[4],q2_,C0,0,0,0),   P1[2],P1[3],P1[4],P1[5],     pw2[0]=PKW(P1,0), pw2[1]=PKW(P1,2), pw2); \
    VRD(6); const bf16x8 q3_=QL(3); SBAR(); GAPA(C1=__builtin_amdgcn_mfma_f32_32x32x16_bf16(kf[5],q2_,C1,0,0,0),   P1[6],P1[7],P1[8],P1[9],     pw2[2]=PKW(P1,4), pw2[3]=PKW(P1,6), pw2); \
    VRD(3); SBAR(); GAPA(C0=__builtin_amdgcn_mfma_f32_32x32x16_bf16(kf[6],q3_,C0,0,0,0),   P1[10],P1[11],P1[12],P1[13], pw3[0]=PKW(P1,8), pw3[1]=PKW(P1,10), pw3); \
    VRD(7); SBAR(); GAPA(C1=__builtin_amdgcn_mfma_f32_32x32x16_bf16(kf[7],q3_,C1,0,0,0),   P1[14],P1[15],0.f,0.f,       pw3[2]=PKW(P1,12),pw3[3]=PKW(P1,14), pw3); \
    l_reg+=sacc; \
    if(GK){DMA_K((t)+3,sl_cur);} if(GV){DMA_V((t)+1,sl_next);} \
    CMASK(C0,C1,t); \
    { float a=MX3(C0[0],C0[1],C1[0]),b=MX3(C0[2],C0[3],C1[1]); a=MX3(a,C1[2],C1[3]); \
      _Pragma("unroll") for(int r=4;r<16;r+=4){a=MX3(a,C0[r],C0[r+1]);b=MX3(b,C0[r+2],C0[r+3]);a=MX3(a,C1[r],C1[r+1]);b=MX3(b,C1[r+2],C1[r+3]);} \
      float rm=__builtin_fmaxf(a,b); { auto rr=__builtin_amdgcn_permlane32_swap(__float_as_uint(rm),__float_as_uint(rm),false,false); rm=__builtin_fmaxf(__uint_as_float(rr[0]),__uint_as_float(rr[1])); } \
      resc=false; \
      if(__builtin_expect(__any(rm>(float)THRL),0)){ const float dl=__builtin_fmaxf(rm,0.f); mhat+=dl; \
        _Pragma("unroll") for(int r=0;r<16;++r){C0[r]-=dl;C1[r]-=dl;} \
        const float f=__builtin_amdgcn_exp2f(-dl); l_reg*=f; if(hi==0)wsf[r32]=f; resc=true; } } \
    SBAR(); \
    GAPB(o[0]=__builtin_amdgcn_mfma_f32_32x32x16_bf16(PAF(0),VFR(0),o[0],0,0,0), C0,0); \
    GAPB(o[1]=__builtin_amdgcn_mfma_f32_32x32x16_bf16(PAF(0),VFR(4),o[1],0,0,0), C0,4); \
    KRD(GL,0); GAPB(o[0]=__builtin_amdgcn_mfma_f32_32x32x16_bf16(PAF(1),VFR(1),o[0],0,0,0), C0,8); \
    KRD(GL,1); GAPB(o[1]=__builtin_amdgcn_mfma_f32_32x32x16_bf16(PAF(1),VFR(5),o[1],0,0,0), C0,12); \
    KRD(GL,2); GAPB(o[0]=__builtin_amdgcn_mfma_f32_32x32x16_bf16(PAF(2),VFR(2),o[0],0,0,0), C1,0); \
    KRD(GL,3); GAPB(o[1]=__builtin_amdgcn_mfma_f32_32x32x16_bf16(PAF(2),VFR(6),o[1],0,0,0), C1,4); \
    GAPB(o[0]=__builtin_amdgcn_mfma_f32_32x32x16_bf16(PAF(3),VFR(3),o[0],0,0,0), C1,8); \
    GAPB(o[1]=__builtin_amdgcn_mfma_f32_32x32x16_bf16(PAF(3),VFR(7),o[1],0,0,0), C1,12); \
    BIASPREP((t)+1); \
    }while(0)
  int t=1;
  #undef CMASK
  #define CMASK(P0,P1,t) do{}while(0)
  for(;t+5<NT;t+=2){
    STEP(pB0,pB1,pA0,pA1,t,true,true,true);     WAIT_BAR(2); RESC(); ROT();
    STEP(pA0,pA1,pB0,pB1,t+1,true,true,true);   WAIT_BAR(2); RESC(); ROT();
  }
  #undef CMASK
  #define CMASK(P0,P1,t) do{int jb_=(t)-(NT-4); if(jb_>=0)cmask(P0,P1,jb_,qrel,hi);}while(0)
  #define ENDW(tt) do{ if((tt)+3<NT){WAIT_BAR(2);} else if((tt)+2<NT){WAIT_BAR(1);} else {WAIT_BAR(0);} }while(0)
  for(;t+1<NT;t+=2){
    STEP(pB0,pB1,pA0,pA1,t,(t+3<NT),(t+1<NT),(t+1<NT));       ENDW(t);   RESC(); ROT();
    STEP(pA0,pA1,pB0,pB1,t+1,(t+4<NT),(t+2<NT),(t+2<NT));     ENDW(t+1); RESC(); ROT();
  }
  STEP(pB0,pB1,pA0,pA1,NT-1,false,false,false); RESC();
  { float sacc=pB0[0]+pB0[1]; _Pragma("unroll") for(int r=2;r<16;++r)sacc+=pB0[r]; _Pragma("unroll") for(int r=0;r<16;++r)sacc+=pB1[r]; l_reg+=sacc;
    pw0=(u32x4){PKW(pB0,0),PKW(pB0,2),PKW(pB0,4),PKW(pB0,6)};pw1=(u32x4){PKW(pB0,8),PKW(pB0,10),PKW(pB0,12),PKW(pB0,14)};pw2=(u32x4){PKW(pB1,0),PKW(pB1,2),PKW(pB1,4),PKW(pB1,6)};pw3=(u32x4){PKW(pB1,8),PKW(pB1,10),PKW(pB1,12),PKW(pB1,14)};
    SBAR(); pv(o,vb0+sl_cur,PAF(0),PAF(1),PAF(2),PAF(3)); }
  #undef PKW
  #undef PAF
  #undef VFR
  #undef PIN
  #undef MX3
  #undef GAPA
  #undef GAPB
  #undef EX
  #undef VRD
  #undef KRD
  #undef STEP
  #undef ENDW
  {auto rr=__builtin_amdgcn_permlane32_swap(__float_as_uint(l_reg),__float_as_uint(l_reg),false,false);l_reg=__uint_as_float(rr[0])+__uint_as_float(rr[1]);}
  if(hi==0)wsf[32+r32]=l_reg;asm volatile("s_waitcnt lgkmcnt(0)":::"memory");
  float rli[16];
  #pragma unroll
  for(int r=0;r<16;++r)rli[r]=__builtin_amdgcn_rcpf(wsf[32+crow(r,hi)]);
  bf16*Ow=const_cast<bf16*>(Qu)+dO+(long)(wid*QBLK)*DM; const bf16*Gw=Qu+dG+(long)(wid*QBLK)*DM; const bool dost=((stmask>>wid)&1u)!=0u;
  { bf16*stg=(bf16*)(shm+LDS_OST)+wid*2048;
    #pragma unroll
    for(int r=0;r<16;++r){const int orow=crow(r,hi);
      #pragma unroll
      for(int d0=0;d0<2;++d0)stg[orow*64+d0*32+r32]=__float2bfloat16(o[d0][r]*rli[r]);}
    asm volatile("s_waitcnt lgkmcnt(0)":::"memory");
    int le_=lane; asm volatile("":"+v"(le_));
    #pragma unroll
    for(int i=0;i<4;++i){const int row=i*8+(le_>>3),ch=le_&7; const u32x4 v=*(const u32x4*)(stg+row*64+ch*8);
      if(dost){ const u32x4 g=*(const u32x4*)(Gw+(long)row*DM+ch*8); u32x4 w;
        #pragma unroll
        for(int j=0;j<4;++j){ const float vl=__uint_as_float(v[j]<<16),vh=__uint_as_float(v[j]&0xffff0000u),gl=__uint_as_float(g[j]<<16),gh=__uint_as_float(g[j]&0xffff0000u); w[j]=cvtpk_s(vl*gl,vh*gh); }
        ATTN_STORE16(Ow+(long)row*DM+ch*8,w);} } }
  asm volatile("s_waitcnt lgkmcnt(0)\n\ts_barrier":::"memory");
  #undef DMA_K
  #undef DMA_V
  #undef BIASMF
  #undef BIASPREP
  #undef QL
  #undef CMASK
  #undef START
  #undef RESC
  #undef ROT
}
constexpr int ATTN_LDS_BYTES=LDS_BYTES;
#undef SBAR
#undef WAIT_BAR
}
#define GAS __attribute__((address_space(1)))
#define LAS __attribute__((address_space(3)))
typedef unsigned short bf16;
typedef unsigned v4u __attribute__((ext_vector_type(4)));
typedef unsigned v2u __attribute__((ext_vector_type(2)));
typedef float f32x4 __attribute__((ext_vector_type(4)));
typedef short bf16x8 __attribute__((ext_vector_type(8)));
#define LDS_WAIT() asm volatile("s_waitcnt lgkmcnt(0)" ::: "memory")
constexpr int NWAVES = 8, NTHREADS = 512;
constexpr int LDS_BYTES = 147456;
constexpr size_t MiB = 1u << 20;
constexpr size_t WS_WGU00 = 1 * MiB, WS_WGU01 = 12 * MiB, WS_WKVF = 23 * MiB, WS_WGU10 = WS_WKVF + 4608 * 1024  , WS_WGU11 = WS_WGU10 + 11 * MiB;
constexpr size_t WS_WDN = WS_WGU11 + 11 * MiB  , WDN_BYTES = (size_t)1024 * 2816 * 2  ;
constexpr size_t WS_WIN = WS_WDN + 4 * WDN_BYTES  , WS_WOA = WS_WIN + (size_t)K::NIN * 1024 * 2  , WS_WQG = WS_WOA + 2 * MiB, WS_WOB = WS_WQG + 4 * MiB  ;
constexpr size_t WS_HB = 86 * MiB, WS_PSQ = 152 * MiB, WS_GL = 155 * MiB, WS_OSQ = 158 * MiB, WS_CP = 167 * MiB, WS_CS = 169 * MiB;
constexpr size_t WS_ACT = 182 * MiB, WS_O = WS_ACT  ;
constexpr size_t WS_KS = 364 * MiB, WS_VS = 500 * MiB;
constexpr size_t WS_GQ = 636 * MiB, WS_GK = 669 * MiB, WS_GV = 702 * MiB, WS_GR = 768 * MiB, WS_OB = 834 * MiB;
constexpr size_t WS_QP = 636 * MiB  , WS_KP = 703 * MiB, WS_VP = 767 * MiB, WS_GATE = 831 * MiB, WS_AO = 900 * MiB, WS_END = 966 * MiB;
static_assert(WS_WGU10 - WS_WKVF == (size_t)K::NKVF * 1024 * 2, "kvf | gu10 contiguous");
static_assert(WS_WOB + 2 * MiB <= WS_HB && WS_HB + (size_t)K::M * 2048 <= WS_PSQ && WS_PSQ + (size_t)K::M * 64 <= WS_GL && WS_GL + (size_t)K::M * 64 <= WS_OSQ && WS_OSQ + (size_t)K::M * 256 <= WS_CP, "map1");
static_assert(WS_CP + 2 * MiB <= WS_CS && WS_CS + (size_t)256 * K::SKR * 4 <= WS_CP + 7 * MiB && WS_CS + 7 * MiB + (size_t)256 * K::SKR * 4 <= WS_ACT && WS_ACT + (size_t)K::M * K::FF * 2 <= WS_KS && WS_O + (size_t)K::M * 4096 <= WS_KS, "map2");
static_assert(WS_KS + (size_t)16 * K::SKR * 2048 <= WS_VS && WS_VS + (size_t)16 * K::SKR * 2048 <= WS_GQ, "map3");
static_assert(WS_GQ + (size_t)K::M * 1024 <= WS_GK && WS_GK + (size_t)K::M * 1024 <= WS_GV && WS_GV + (size_t)K::M * 2048 <= WS_GR && WS_GR + (size_t)K::M * 2048 <= WS_OB && WS_OB + (size_t)K::M * 2048 <= WS_AO, "map4");
static_assert(WS_QP + (size_t)(K::M + 192) * 2048 <= WS_KP && WS_KP + 64 * MiB <= WS_VP && WS_VP + 64 * MiB <= WS_GATE && WS_GATE + (size_t)K::M * 2048 <= WS_AO && WS_AO + (size_t)K::M * 2048 <= WS_END, "map5");

struct Args {
    const float *x_p, *x_s, *state, *cache_k, *cache_v, *cache_lf, *ffn_norm, *w_gu, *w_dn, *mix_norm, *a_w_in, *a_w_g2, *a_b_g, *a_g_out, *a_w_o, *kv_norm, *w_kvf, *b_f, *g_k, *b_w_qg, *b_g_q, *b_w_o;
    float* out; unsigned char* ws;
};

__device__ __forceinline__ float wave_sum(float v) {
#pragma unroll
    for (int o = 1; o < 64; o <<= 1) v += __shfl_xor(v, o);
    return v;
}
__device__ __forceinline__ float bf2f(unsigned short u) { return __uint_as_float((unsigned)u << 16); }
__device__ __forceinline__ unsigned short f2bf(float f) { return (unsigned short)(pg8::pkbf(f, 0.f) & 0xffffu); }

__device__ __forceinline__ void tr_item(const float* W, int ldw, int nvalid, const float* gain, bf16* WT, int Kd, int k0, int nsrc0, int ndst0, LAS float* scr, int lane) {
    const int n = nsrc0 + (lane & 31); const bool ok = n < nvalid;
    float wv_[32];
#pragma unroll
    for (int i = 0; i < 32; ++i) { const int kk = 2 * i + (lane >> 5); wv_[i] = ok ? W[(size_t)(k0 + kk) * ldw + n] : 0.f; }
#pragma unroll
    for (int i = 0; i < 32; ++i) { const int kk = 2 * i + (lane >> 5); float v = wv_[i]; if (gain) v *= gain[k0 + kk]; scr[kk * 33 + (lane & 31)] = v; }
    LDS_WAIT(); asm volatile("" ::: "memory");
    const int c = lane & 7;
#pragma unroll
    for (int j = 0; j < 4; ++j) { const int nn = (lane >> 3) + 8 * j; const LAS float* s = scr + (8 * c) * 33 + nn;
        v4u o; o.x = pg8::pkbf(s[0 * 33], s[1 * 33]); o.y = pg8::pkbf(s[2 * 33], s[3 * 33]); o.z = pg8::pkbf(s[4 * 33], s[5 * 33]); o.w = pg8::pkbf(s[6 * 33], s[7 * 33]);
        *(v4u*)(WT + (size_t)(ndst0 + nn) * Kd + k0 + 8 * c) = o; }
    LDS_WAIT(); asm volatile("" ::: "memory");
}
__device__ __forceinline__ int headperm32(int n) { const int pn = n >> 8, nl = n & 255; return pn * 256 + ((nl & 63) >> 5) * 128 + (nl >> 6) * 32; }
__device__ __forceinline__ int guperm32(int n) { if (n < K::FF) return (n >> 7) * 256 + (n & 127); const int j = n - K::FF; return (j >> 7) * 256 + 128 + (j & 127); }

__device__ __forceinline__ void p0_prologue(const Args& A, LAS unsigned char* lds, int gw, int NGW, int lane, int wave) {
    unsigned char* ws = A.ws;
    LAS float* scr = (LAS float*)(lds + wave * 16384);
    constexpr int I_GU = 16 * (K::NGU / 32), I_DN = (K::FF / 64) * 32, I_IN = 16 * (K::NIN / 32), I_OA = 16 * 32, I_KVF = 16 * (K::NKVF / 32), I_QG = 16 * (K::NQG / 32), I_OB = 16 * 32;
    constexpr int NITEMS = 4 * I_GU + 4 * I_DN + I_IN + I_OA + I_KVF + I_QG + I_OB;
    for (int it = gw; it < NITEMS; it += NGW) {
        int r = it;
        if (r < 4 * I_GU) { const int mi = r / I_GU; r -= mi * I_GU; const int nb = r % (K::NGU / 32), kb = r / (K::NGU / 32);
            const size_t wsoff = mi == 0 ? WS_WGU00 : mi == 1 ? WS_WGU01 : mi == 2 ? WS_WGU10 : WS_WGU11;
            tr_item(A.w_gu + (size_t)mi * 1024 * K::NGU, K::NGU, K::NGU, A.ffn_norm + mi * 1024, (bf16*)(ws + wsoff), 1024, kb * 64, nb * 32, guperm32(nb * 32), scr, lane); continue; }
        r -= 4 * I_GU;
        if (r < 4 * I_DN) { const int mi = r / I_DN; r -= mi * I_DN; const int nb = r % 32, kb = r / 32;
            tr_item(A.w_dn + (size_t)mi * K::FF * 1024, 1024, 1024, nullptr, (bf16*)(ws + WS_WDN + mi * WDN_BYTES), K::FF, kb * 64, nb * 32, nb * 32, scr, lane); continue; }
        r -= 4 * I_DN;
        if (r < I_IN) { const int nb = r % (K::NIN / 32), kb = r / (K::NIN / 32);
            tr_item(A.a_w_in, K::NIN_SRC, K::NIN_SRC, A.mix_norm, (bf16*)(ws + WS_WIN), 1024, kb * 64, nb * 32, nb * 32, scr, lane); continue; }
        r -= I_IN;
        if (r < I_OA) { const int nb = r % 32, kb = r / 32; tr_item(A.a_w_o, 1024, 1024, nullptr, (bf16*)(ws + WS_WOA), 1024, kb * 64, nb * 32, nb * 32, scr, lane); continue; }
        r -= I_OA;
        if (r < I_KVF) { const int nb = r % (K::NKVF / 32), kb = r / (K::NKVF / 32);
            tr_item(A.w_kvf, K::NKVF_SRC, K::NKVF_SRC, A.kv_norm, (bf16*)(ws + WS_WKVF), 1024, kb * 64, nb * 32, headperm32(nb * 32), scr, lane); continue; }
        r -= I_KVF;
        if (r < I_QG) { const int nb = r % (K::NQG / 32), kb = r / (K::NQG / 32);
            tr_item(A.b_w_qg, K::NQG, K::NQG, A.mix_norm + 1024, (bf16*)(ws + WS_WQG), 1024, kb * 64, nb * 32, headperm32(nb * 32), scr, lane); continue; }
        r -= I_QG;
        { const int nb = r % 32, kb = r / 32; tr_item(A.b_w_o, 1024, 1024, nullptr, (bf16*)(ws + WS_WOB), 1024, kb * 64, nb * 32, nb * 32, scr, lane); }
    }
    bf16* HB = (bf16*)(ws + WS_HB); float* PSQ = (float*)(ws + WS_PSQ);
    for (int m0 = gw; m0 < K::M; m0 += 2 * NGW) {
        f32x4 v[2][4]; float s[2];
#pragma unroll
        for (int rr = 0; rr < 2; ++rr) { const int m = m0 + rr * NGW; if (m < K::M) { const float* xr = (m < K::MP) ? A.x_p + (size_t)m * 1024 : A.x_s + (size_t)(m - K::MP) * 1024; const f32x4* x4 = (const f32x4*)xr + lane;
#pragma unroll
                for (int j = 0; j < 4; ++j) v[rr][j] = x4[64 * j]; } }
#pragma unroll
        for (int rr = 0; rr < 2; ++rr) { const int m = m0 + rr * NGW; if (m < K::M) { s[rr] = 0.f;
#pragma unroll
                for (int j = 0; j < 4; ++j) s[rr] += (v[rr][j][0] * v[rr][j][0] + v[rr][j][1] * v[rr][j][1]) + (v[rr][j][2] * v[rr][j][2] + v[rr][j][3] * v[rr][j][3]);
                s[rr] = wave_sum(s[rr]);
                v2u* o8 = (v2u*)(HB + (size_t)m * 1024) + lane;
#pragma unroll
                for (int j = 0; j < 4; ++j) { v2u w; w.x = pg8::pkbf(v[rr][j][0], v[rr][j][1]); w.y = pg8::pkbf(v[rr][j][2], v[rr][j][3]); o8[64 * j] = w; }
                if (lane < 16) PSQ[(size_t)m * 16 + lane] = (lane == 0) ? s[rr] : 0.f;
 } }
    }
    {
        const size_t tid_g = (size_t)gw * 64 + lane, nth = (size_t)NGW * 64;
        const size_t nvec = (size_t)16 * K::PAST * 1024 / 8;
        for (int which = 0; which < 2; ++which) {
            const float* src = which ? A.cache_v : A.cache_k; bf16* dst = (bf16*)(ws + (which ? WS_VS : WS_KS));
            const size_t nz = (size_t)16 * 192 * 1024 / 8;
            for (size_t i = tid_g; i < nz; i += nth) { const size_t e = i * 8, b = e / (192 * 1024), rem = e - b * 192 * 1024; *(v4u*)(dst + (b * K::SKR + K::PAST + 64) * 1024 + rem) = (v4u){0u, 0u, 0u, 0u}; }
        }
    }
}

constexpr size_t WS_QE = 900 * MiB, WS_KDT = 933 * MiB, WS_ATT = 314 * MiB, WS_DEC = 331 * MiB, WS_VT = WS_VS  ;
static_assert(WS_O + (size_t)K::M * 4096 <= WS_ATT && WS_ATT + (size_t)2112 * 8192 <= WS_DEC && WS_DEC + (size_t)2112 * 512 <= WS_KS && WS_QE + (size_t)2112 * 16384 <= WS_KDT && WS_KDT + (size_t)2112 * 16384 <= WS_END, "gla map");
struct PrepIn { unsigned short qv[16], kv[16]; unsigned vpk[16]; f32x4 gl; float w2[16]; float bg; };
__device__ __forceinline__ void gla_prep_load(PrepIn& I, const Args& A, int it, int tid) {
    unsigned char* ws = A.ws; const bf16* GQ = (const bf16*)(ws + WS_GQ); const bf16* GK = (const bf16*)(ws + WS_GK); const bf16* GV = (const bf16*)(ws + WS_GV); const float* GL = (const float*)(ws + WS_GL);
    const int h = it & 3, m0 = (it >> 2) * 64, d = tid & 127, tg = tid >> 7, ve_ = tid & 255, vh_ = tid >> 8;
#pragma unroll
    for (int j = 0; j < 16; ++j) I.w2[j] = A.a_w_g2[j * 512 + h * 128 + d];
    I.bg = A.a_b_g[h * 128 + d];
    I.gl = (tid < 256) ? *(const f32x4*)(GL + (size_t)m0 * 16 + tid * 4) : (f32x4){0.f, 0.f, 0.f, 0.f};
#pragma unroll
    for (int i = 0; i < 16; ++i) { const size_t o = (size_t)(m0 + tg * 16 + i) * 512 + h * 128 + d; I.qv[i] = GQ[o]; I.kv[i] = GK[o]; }
#pragma unroll
    for (int i = 0; i < 16; ++i) { const unsigned a = GV[(size_t)(m0 + vh_ * 32 + 2 * i) * 1024 + h * 256 + ve_], b2 = GV[(size_t)(m0 + vh_ * 32 + 2 * i + 1) * 1024 + h * 256 + ve_]; I.vpk[i] = a | (b2 << 16); }
}
__device__ __forceinline__ void gla_prep_item(const Args& A, LAS unsigned char* lds, int it, int tid, PrepIn& I, int it_next) {
    const int lane = tid & 63, w = __builtin_amdgcn_readfirstlane(tid >> 6), fr = lane & 15, fq = lane >> 4;
    unsigned char* ws = A.ws;
    LAS bf16* Qe = (LAS bf16*)(lds);
    LAS bf16* Ke = (LAS bf16*)(lds + 17408);
    LAS float* glS = (LAS float*)(lds + 34816);
    LAS float* part = (LAS float*)(lds + 38912);
    bf16* QE = (bf16*)(ws + WS_QE); bf16* KDT = (bf16*)(ws + WS_KDT); bf16* ATT = (bf16*)(ws + WS_ATT); float* DEC = (float*)(ws + WS_DEC); bf16* VT = (bf16*)(ws + WS_VT);
    const int h = it & 3, m0 = (it >> 2) * 64; (void)m0;
    const int d = tid & 127, tg = tid >> 7;
    float w2[16];
#pragma unroll
    for (int j = 0; j < 16; ++j) w2[j] = I.w2[j];
    const float bg = I.bg;
    if (tid < 256) *(LAS f32x4*)(glS + tid * 4) = I.gl;
    unsigned short qv[16], kv[16]; unsigned vpk[16];
#pragma unroll
    for (int i = 0; i < 16; ++i) { qv[i] = I.qv[i]; kv[i] = I.kv[i]; vpk[i] = I.vpk[i]; }
    const int ve_ = tid & 255, vh_ = tid >> 8;
    __syncthreads();
    float bl[16]; float run = 0.f;
#pragma unroll
    for (int i = 0; i < 16; ++i) { const LAS f32x4* g4 = (const LAS f32x4*)(glS + (tg * 16 + i) * 16); float z = bg;
#pragma unroll
        for (int j4 = 0; j4 < 4; ++j4) { const f32x4 g = g4[j4]; z += g[0] * w2[4 * j4] + g[1] * w2[4 * j4 + 1] + g[2] * w2[4 * j4 + 2] + g[3] * w2[4 * j4 + 3]; }
        run += pg8::logsigmoid_f(z) * (1.0f / 16.0f); bl[i] = run; }
    part[tg * 128 + d] = run;
    __syncthreads();
    float prefix = 0.f, tot = 0.f;
#pragma unroll
    for (int g = 0; g < 4; ++g) { const float pv = part[g * 128 + d]; tot += pv; if (g < tg) prefix += pv; }
    const float dect_ = __builtin_amdgcn_exp2f(tot * K::LOG2E);
    if (tg == 0) DEC[(size_t)it * 128 + d] = dect_;
    {
        float kd[16];
#pragma unroll
        for (int i = 0; i < 16; ++i) { const int l = tg * 16 + i; const float bb = (prefix + bl[i]) * K::LOG2E; const float q = bf2f(qv[i]), k = bf2f(kv[i]);
            const unsigned short qe = f2bf(q * __builtin_amdgcn_exp2f(bb));
            Qe[l * 136 + d] = qe; QE[((size_t)it * 64 + l) * 128 + d] = qe; const float ke_ = k * __builtin_amdgcn_exp2f(-bb); Ke[l * 136 + d] = f2bf(ke_); kd[i] = ke_ * dect_; }
        v4u p0, p1; p0.x = pg8::pkbf(kd[0], kd[1]); p0.y = pg8::pkbf(kd[2], kd[3]); p0.z = pg8::pkbf(kd[4], kd[5]); p0.w = pg8::pkbf(kd[6], kd[7]);
        p1.x = pg8::pkbf(kd[8], kd[9]); p1.y = pg8::pkbf(kd[10], kd[11]); p1.z = pg8::pkbf(kd[12], kd[13]); p1.w = pg8::pkbf(kd[14], kd[15]);
        v4u* kdst = (v4u*)(KDT + ((size_t)it * 128 + d) * 64 + tg * 16); kdst[0] = p0; kdst[1] = p1;
    }
    {
        v4u* vdst = (v4u*)(VT + ((size_t)it * 256 + ve_) * 64 + vh_ * 32);
#pragma unroll
        for (int i = 0; i < 4; ++i) vdst[i] = (v4u){vpk[4 * i], vpk[4 * i + 1], vpk[4 * i + 2], vpk[4 * i + 3]};
    }
    if (it_next < 2112) gla_prep_load(I, A, it_next, tid);
    __syncthreads();
#pragma unroll
    for (int i = 0; i < 2; ++i) { const int ti = w * 2 + i, mt = ti >> 2, lt = ti & 3; f32x4 acc = {0.f, 0.f, 0.f, 0.f};
#pragma unroll
        for (int kk = 0; kk < 4; ++kk) { const bf16x8 a = *(const LAS bf16x8*)(Ke + (mt * 16 + fr) * 136 + kk * 32 + 8 * fq), bq = *(const LAS bf16x8*)(Qe + (lt * 16 + fr) * 136 + kk * 32 + 8 * fq);
            acc = __builtin_amdgcn_mfma_f32_16x16x32_bf16(a, bq, acc, 0, 0, 0); }
        const int l = lt * 16 + fr, mb = mt * 16 + 4 * fq;
#pragma unroll
        for (int r = 0; r < 4; ++r) if (mb + r > l) acc[r] = 0.f;
        v2u pk; pk.x = pg8::pkbf(acc[0], acc[1]); pk.y = pg8::pkbf(acc[2], acc[3]); *(v2u*)(ATT + ((size_t)it * 64 + l) * 64 + mb) = pk; }
    __syncthreads();
}

constexpr size_t WS_SS = WS_O;
struct ScanFrags { bf16x8 aK[2], bV[2][2]; f32x4 dc; };
__device__ __forceinline__ void scan_load(ScanFrags& F, const unsigned char* ws, int it, int es, int w, int fr, int fq) {
    const bf16* KDT = (const bf16*)(ws + WS_KDT); const float* DEC = (const float*)(ws + WS_DEC); const bf16* VT = (const bf16*)(ws + WS_VT);
#pragma unroll
    for (int kk = 0; kk < 2; ++kk) { F.aK[kk] = *(const bf16x8*)(KDT + ((size_t)it * 128 + w * 16 + fr) * 64 + kk * 32 + 8 * fq);
#pragma unroll
        for (int t = 0; t < 2; ++t) F.bV[t][kk] = *(const bf16x8*)(VT + ((size_t)it * 256 + es * 32 + t * 16 + fr) * 64 + kk * 32 + 8 * fq); }
    F.dc = *(const f32x4*)(DEC + (size_t)it * 128 + w * 16 + 4 * fq);
}
template <int NCH> __device__ __forceinline__ void gla_scan_item(const Args& A, int b, int h, int es, int tid) {
    const int lane = tid & 63, w = __builtin_amdgcn_readfirstlane(tid >> 6), fr = lane & 15, fq = lane >> 4;
    unsigned char* ws = A.ws; bf16* SS = (bf16*)(ws + WS_SS);
    constexpr bool samp = NCH == 1; constexpr int PF = NCH == 1 ? 1 : 7;
    const int ci0 = samp ? 512 + b : b * 64;
    f32x4 S[2];
#pragma unroll
    for (int t = 0; t < 2; ++t)
#pragma unroll
        for (int r = 0; r < 4; ++r) S[t][r] = samp ? A.state[((size_t)(b * 4 + h) * 128 + (w * 16 + 4 * fq + r)) * 256 + es * 32 + t * 16 + fr] : 0.f;
    ScanFrags F[PF];
    if (NCH == 1) scan_load(F[0], ws, ci0 * 4 + h, es, w, fr, fq);
    else {
#pragma unroll
        for (int c = 0; c < PF - 1; ++c) scan_load(F[c], ws, (ci0 + c) * 4 + h, es, w, fr, fq);
    }
#pragma unroll
    for (int c = 0; c < NCH; ++c) {
        if (NCH > 1 && c + PF - 1 < NCH) scan_load(F[(c + PF - 1) % PF], ws, (ci0 + c + PF - 1) * 4 + h, es, w, fr, fq);
        const int it = (ci0 + c) * 4 + h;
#pragma unroll
        for (int t = 0; t < 2; ++t) {
            v2u pk; pk.x = pg8::pkbf(S[t][0], S[t][1]); pk.y = pg8::pkbf(S[t][2], S[t][3]);
            *(v2u*)(SS + ((size_t)it * 256 + es * 32 + t * 16 + fr) * 128 + w * 16 + 4 * fq) = pk;
#pragma unroll
            for (int r = 0; r < 4; ++r) S[t][r] *= F[c % PF].dc[r];
#pragma unroll
            for (int kk = 0; kk < 2; ++kk) S[t] = __builtin_amdgcn_mfma_f32_16x16x32_bf16(F[c % PF].aK[kk], F[c % PF].bV[t][kk], S[t], 0, 0, 0); }
    }
    float* so = A.out + (samp ? K::O_GLAS : K::O_GLAP);
#pragma unroll
    for (int t = 0; t < 2; ++t)
#pragma unroll
        for (int r = 0; r < 4; ++r) so[((size_t)(b * 4 + h) * 128 + (w * 16 + 4 * fq + r)) * 256 + es * 32 + t * 16 + fr] = S[t][r];
}

struct OutB { bf16x8 bS[2][4], bV[2][2]; };
__device__ __forceinline__ void gla_out_loadB(OutB& B, const unsigned char* ws, int it, int w, int fr, int fq) {
    const bf16* VT = (const bf16*)(ws + WS_VT); const bf16* SS = (const bf16*)(ws + WS_SS);
#pragma unroll
    for (int t = 0; t < 2; ++t) {
#pragma unroll
        for (int kk = 0; kk < 4; ++kk) B.bS[t][kk] = *(const bf16x8*)(SS + ((size_t)it * 256 + w * 32 + t * 16 + fr) * 128 + kk * 32 + 8 * fq);
#pragma unroll
        for (int kk = 0; kk < 2; ++kk) B.bV[t][kk] = *(const bf16x8*)(VT + ((size_t)it * 256 + w * 32 + t * 16 + fr) * 64 + kk * 32 + 8 * fq); }
}
__device__ __forceinline__ void gla_out_item(const Args& A, LAS unsigned char* lds, int it, int tid, OutB& Bc, int it_next) {
    const int lane = tid & 63, w = __builtin_amdgcn_readfirstlane(tid >> 6), fr = lane & 15, fq = lane >> 4;
    unsigned char* ws = A.ws;
    const bf16* QE = (const bf16*)(ws + WS_QE); const bf16* ATT = (const bf16*)(ws + WS_ATT); const bf16* VT = (const bf16*)(ws + WS_VT); const bf16* SS = (const bf16*)(ws + WS_SS);
    const bf16* GR = (const bf16*)(ws + WS_GR); bf16* OB = (bf16*)(ws + WS_OB);
    LAS float* OT = (LAS float*)lds;
    const int h = it & 3, m0 = (it >> 2) * 64;
#pragma unroll
    for (int lt = 0; lt < 4; ++lt) {
        bf16x8 aQ[4], aA[2];
#pragma unroll
        for (int kk = 0; kk < 4; ++kk) aQ[kk] = *(const bf16x8*)(QE + ((size_t)it * 64 + lt * 16 + fr) * 128 + kk * 32 + 8 * fq);
#pragma unroll
        for (int kk = 0; kk < 2; ++kk) aA[kk] = *(const bf16x8*)(ATT + ((size_t)it * 64 + lt * 16 + fr) * 64 + kk * 32 + 8 * fq);
#pragma unroll
        for (int t = 0; t < 2; ++t) { f32x4 acc = {0.f, 0.f, 0.f, 0.f};
#pragma unroll
            for (int kk = 0; kk < 4; ++kk) acc = __builtin_amdgcn_mfma_f32_16x16x32_bf16(aQ[kk], Bc.bS[t][kk], acc, 0, 0, 0);
#pragma unroll
            for (int kk = 0; kk < 2; ++kk) acc = __builtin_amdgcn_mfma_f32_16x16x32_bf16(aA[kk], Bc.bV[t][kk], acc, 0, 0, 0);
#pragma unroll
            for (int r = 0; r < 4; ++r) OT[(lt * 16 + 4 * fq + r) * 260 + w * 32 + t * 16 + fr] = acc[r]; }
    }
    if (it_next < 2112) gla_out_loadB(Bc, ws, it_next, w, fr, fq);
    const int c8 = tid & 31;
    const f32x4 g0 = *(const f32x4*)(A.a_g_out + c8 * 8), g1 = *(const f32x4*)(A.a_g_out + c8 * 8 + 4);
    v4u rrv[4];
#pragma unroll
    for (int p = 0; p < 4; ++p) rrv[p] = *(const v4u*)(GR + (size_t)(m0 + p * 16 + (tid >> 5)) * 1024 + h * 256 + c8 * 8);
    __syncthreads();
#pragma unroll
    for (int p = 0; p < 4; ++p) { const int l = p * 16 + (tid >> 5);
        const f32x4 o0 = *(const LAS f32x4*)(OT + l * 260 + c8 * 8), o1 = *(const LAS f32x4*)(OT + l * 260 + c8 * 8 + 4);
        float s = (o0[0] * o0[0] + o0[1] * o0[1]) + (o0[2] * o0[2] + o0[3] * o0[3]) + (o1[0] * o1[0] + o1[1] * o1[1]) + (o1[2] * o1[2] + o1[3] * o1[3]);
        s += __shfl_xor(s, 1); s += __shfl_xor(s, 2); s += __shfl_xor(s, 4); s += __shfl_xor(s, 8); s += __shfl_xor(s, 16);
        const float rstd = __builtin_amdgcn_rsqf(s * (1.0f / 256.0f) + K::EPS);
        const size_t go = (size_t)(m0 + l) * 1024 + h * 256 + c8 * 8; const v4u rr = rrv[p];
        f32x4 a, b2;
#pragma unroll
        for (int j = 0; j < 2; ++j) { a[2 * j] = o0[2 * j] * rstd * g0[2 * j] * __uint_as_float(rr[j] << 16); a[2 * j + 1] = o0[2 * j + 1] * rstd * g0[2 * j + 1] * __uint_as_float(rr[j] & 0xffff0000u);
            b2[2 * j] = o1[2 * j] * rstd * g1[2 * j] * __uint_as_float(rr[2 + j] << 16); b2[2 * j + 1] = o1[2 * j + 1] * rstd * g1[2 * j + 1] * __uint_as_float(rr[2 + j] & 0xffff0000u); }
        *(v4u*)(OB + go) = pg8::pk8(a, b2); }
    __syncthreads();
}

__device__ __forceinline__ void logf_cumsum(const Args& A, int vcu, int wave, int G, int lane) {
    for (int s0 = wave * G + vcu; s0 < 384; s0 += NWAVES * G) {
        const bool samp = s0 >= 128; const int s = samp ? s0 - 128 : s0; const int b = s >> 4, h = s & 15;
        float* dst = samp ? (float*)(A.ws + WS_CS) + (size_t)s * K::SKR : (float*)(A.ws + WS_CP) + (size_t)s * K::SEQ;
        float v[65];
#pragma unroll
        for (int t = 0; t < 64; ++t) { const int pos = t * 64 + lane; v[t] = samp ? A.cache_lf[((size_t)b * K::PAST + pos) * 16 + h] : A.out[K::O_LFP + ((size_t)b * K::SEQ + pos) * 16 + h]; }
        v[64] = samp ? A.out[K::O_LFS + ((size_t)b * 64 + lane) * 16 + h] : 0.f;
        float carry = 0.f;
#pragma unroll
        for (int t = 0; t < 65; ++t) { if (t < 64 || samp) { float x = v[t];
#pragma unroll
                for (int o = 1; o < 64; o <<= 1) { const float y = __shfl_up(x, o); if (lane >= o) x += y; }
                x += carry; const float nk = -x * K::LOG2E; dst[t * 64 + lane] = nk; carry = __shfl(x, 63);
                const float bb = nk - __shfl(nk, 0); const unsigned bh = pg8::pkbf(bb, 0.f) & 0xffffu, bl = pg8::pkbf(bb - __uint_as_float(bh << 16), 0.f) & 0xffffu;
                ((unsigned*)((char*)dst + (7u << 20)))[t * 64 + lane] = bh | (bl << 16); } }
        if (samp) { const float last = -carry * K::LOG2E; dst[4160 + lane] = last; dst[4224 + lane] = last; dst[4288 + lane] = last; unsigned* kxp = (unsigned*)((char*)dst + (7u << 20)); kxp[4160 + lane] = 0u; kxp[4224 + lane] = 0u; kxp[4288 + lane] = 0u; }
    }
}

constexpr size_t WS_PART = WS_AO;
__device__ __forceinline__ void fixup_sample_rows(const Args& A, int wave, int aux) {
    const int lane = lane_id_(), G = gridDim.x, bx = blockIdx.x, vcu = (G % 8 == 0) ? (bx % 8) * (G / 8) + bx / 8 : bx, gw = vcu * NWAVES + wave, NGW = G * NWAVES;
    unsigned char* ws = A.ws; const float* PART = (const float*)(ws + WS_PART); bf16* HB = (bf16*)(ws + WS_HB); float* PSQ = (float*)(ws + WS_PSQ);
    for (int r = gw; r < K::MS; r += NGW) {
        const size_t m = (size_t)K::MP + r; f32x4 v[4]; float s = 0.f;
#pragma unroll
        for (int j = 0; j < 4; ++j) { const v2u hw = *((const v2u*)(HB + m * 1024) + lane + 64 * j);
            v[j][0] = __uint_as_float(hw.x << 16); v[j][1] = __uint_as_float(hw.x & 0xffff0000u); v[j][2] = __uint_as_float(hw.y << 16); v[j][3] = __uint_as_float(hw.y & 0xffff0000u); }
#pragma unroll
        for (int p = 0; p < 11; ++p)
#pragma unroll
            for (int j = 0; j < 4; ++j) v[j] = v[j] + *((const f32x4*)(PART + ((size_t)p * K::MS + r) * 1024) + lane + 64 * j);
        if (aux) {
#pragma unroll
            for (int j = 0; j < 4; ++j) { s += (v[j][0] * v[j][0] + v[j][1] * v[j][1]) + (v[j][2] * v[j][2] + v[j][3] * v[j][3]); v2u w; w.x = pg8::pkbf(v[j][0], v[j][1]); w.y = pg8::pkbf(v[j][2], v[j][3]); *((v2u*)(HB + m * 1024) + lane + 64 * j) = w; }
            s = wave_sum(s);
            if (lane < 16) PSQ[m * 16 + lane] = (lane == 0) ? s : 0.f;
        } else {
#pragma unroll
            for (int j = 0; j < 4; ++j) *((f32x4*)(A.out + m * 1024) + lane + 64 * j) = v[j];
        }
    }
}

#define XB_TMO      128
#define XB_XCNT(j)  (256  + 64 * (j))
#define XB_XSUB(j)  (1280 + 64 * (j))
#define XB_XGEN(j)  (2304 + 64 * (j))
#define XB_TOP      3328
#define XB_TOPGEN   3392
#define XCD_BAR_WORDS 3456
#define XB_SPIN_CAP (1u << 18)

__device__ __forceinline__ unsigned xb_ld(unsigned* p)              { return __hip_atomic_load(p, __ATOMIC_RELAXED, __HIP_MEMORY_SCOPE_AGENT); }
__device__ __forceinline__ unsigned xb_add(unsigned* p, unsigned v) { return __hip_atomic_fetch_add(p, v, __ATOMIC_RELAXED, __HIP_MEMORY_SCOPE_AGENT); }
__device__ __forceinline__ unsigned xb_xcc_id() { return (unsigned)__builtin_amdgcn_s_getreg((3 << 11) | 20) & 0xFu; }
#define XB_SPIN(cond, bar) do { unsigned _sp = 0; while (cond) { __builtin_amdgcn_s_sleep(1); \
    if ((++_sp & 255u) == 0u) { if (xb_ld(&(bar)[XB_TMO])) break; if (_sp > XB_SPIN_CAP) { atomicAdd(&(bar)[XB_TMO], 1u); break; } } } } while (0)

struct XcdBarrier {
    unsigned* bar; unsigned x;
    volatile LAS unsigned* st;
};

__device__ __forceinline__ XcdBarrier xcd_barrier_post(unsigned* bar, volatile LAS unsigned* st) {
    XcdBarrier b; b.bar = bar; b.x = xb_xcc_id(); b.st = st;
    if (threadIdx.x == 0) (void)xb_add(&bar[XB_XCNT(b.x)], 1u);
    return b;
}
__device__ __forceinline__ void xcd_barrier_complete(unsigned* bar, unsigned x, unsigned& nloc, unsigned& nx) {
    const unsigned G = gridDim.x * gridDim.y * gridDim.z;
    unsigned sum, cnt, mine, sp = 0u;
    for (;;) {
        sum = 0u; cnt = 0u; mine = 0u;
#pragma unroll
        for (unsigned j = 0; j < 16; ++j) { const unsigned c = xb_ld(&bar[XB_XCNT(j)]); sum += c; cnt += (c > 0u) ? 1u : 0u; mine = (j == x) ? c : mine; }
        if (sum == G) break;
        __builtin_amdgcn_s_sleep(1);
        if ((++sp & 255u) == 0u) { if (xb_ld(&bar[XB_TMO])) break; if (sp > XB_SPIN_CAP) { atomicAdd(&bar[XB_TMO], 1u); break; } }
    }
    nloc = mine > 0u ? mine : 1u; nx = cnt > 0u ? cnt : 1u;
}

__device__ __forceinline__ void xcd_barrier(const XcdBarrier& b, const int wv) {
    const bool leader_ = (wv == 0) && (lane_id_() == 0);
    asm volatile("s_waitcnt vmcnt(0)" ::: "memory");
    __syncthreads();
    if (leader_) {
        unsigned* bar = b.bar;
        __builtin_amdgcn_s_waitcnt(0);
        unsigned nloc = b.st[0], nx = b.st[1];
        if (nloc == 0u) { xcd_barrier_complete(bar, b.x, nloc, nx); b.st[0] = nloc; b.st[1] = nx; }
        const unsigned old = xb_add(&bar[XB_XSUB(b.x)], 1u);
        const unsigned gen = old / nloc;
        if (old + 1u == (gen + 1u) * nloc) {
            __builtin_amdgcn_fence(__ATOMIC_RELEASE, "agent");
            asm volatile("s_waitcnt vmcnt(0)" ::: "memory");
            const unsigned og = xb_add(&bar[XB_TOP], 1u);
            const unsigned tg = og / nx;
            if (og + 1u == (tg + 1u) * nx) xb_add(&bar[XB_TOPGEN], 1u);
            else XB_SPIN(xb_ld(&bar[XB_TOPGEN]) == tg, bar);
            __builtin_amdgcn_fence(__ATOMIC_ACQUIRE, "agent");
            xb_add(&bar[XB_XGEN(b.x)], 1u);
            asm volatile("s_waitcnt vmcnt(0)" ::: "memory");
        } else {
            XB_SPIN(xb_ld(&bar[XB_XGEN(b.x)]) == gen, bar);
            __builtin_amdgcn_fence(__ATOMIC_ACQUIRE, "agent");
            asm volatile("s_waitcnt vmcnt(0)" ::: "memory");
        }
    }
    __syncthreads();
}

__device__ __forceinline__ void stagger_start(bool late, unsigned ticks  ) {
    if (late) { const unsigned long long t0 = __builtin_amdgcn_s_memrealtime(); while (__builtin_amdgcn_s_memrealtime() - t0 < ticks) __builtin_amdgcn_s_sleep(64); }
}
__device__ __forceinline__ bool opaque_true() { int one = 1; asm volatile("" : "+s"(one)); return one != 0; }
__device__ __forceinline__ Args load_args() {
    typedef const __attribute__((address_space(4))) unsigned long long* KP;
    KP kp = (KP)__builtin_amdgcn_kernarg_segment_ptr(); asm volatile("" : "+s"(kp));
    Args a;
    a.x_p = (const float*)(const GAS float*)kp[0]; a.x_s = (const float*)(const GAS float*)kp[1]; a.state = (const float*)(const GAS float*)kp[2]; a.cache_k = (const float*)(const GAS float*)kp[3]; a.cache_v = (const float*)(const GAS float*)kp[4]; a.cache_lf = (const float*)(const GAS float*)kp[5];
    a.ffn_norm = (const float*)(const GAS float*)kp[6]; a.w_gu = (const float*)(const GAS float*)kp[7]; a.w_dn = (const float*)(const GAS float*)kp[8]; a.mix_norm = (const float*)(const GAS float*)kp[9]; a.a_w_in = (const float*)(const GAS float*)kp[10]; a.a_w_g2 = (const float*)(const GAS float*)kp[11];
    a.a_b_g = (const float*)(const GAS float*)kp[12]; a.a_g_out = (const float*)(const GAS float*)kp[13]; a.a_w_o = (const float*)(const GAS float*)kp[14]; a.kv_norm = (const float*)(const GAS float*)kp[15]; a.w_kvf = (const float*)(const GAS float*)kp[16]; a.b_f = (const float*)(const GAS float*)kp[17];
    a.g_k = (const float*)(const GAS float*)kp[18]; a.b_w_qg = (const float*)(const GAS float*)kp[19]; a.b_g_q = (const float*)(const GAS float*)kp[20]; a.b_w_o = (const float*)(const GAS float*)kp[21]; a.out = (float*)(GAS float*)kp[22]; a.ws = (unsigned char*)(GAS unsigned char*)kp[23];
    return a;
}
__global__ void __launch_bounds__(NTHREADS, 2) mega_fwd(Args A_) {
    extern __shared__ __attribute__((aligned(16))) unsigned char lds_raw[];
    LAS unsigned char* lds = (LAS unsigned char*)lds_raw;
    cg::grid_group grid = cg::this_grid();
    const int wave = __builtin_amdgcn_readfirstlane((int)threadIdx.x >> 6);
#define PH_LOCALS const Args A = load_args(); const int lane = lane_id_(), tid = wave * 64 + lane; (void)tid; const int G = gridDim.x, bx = blockIdx.x; const int vcu = (G % 8 == 0) ? (bx % 8) * (G / 8) + bx / 8 : bx; \
        const int gw = vcu * NWAVES + wave, NGW = G * NWAVES; (void)gw; (void)NGW; const XcdBarrier xbar{(unsigned*)A.ws + 4096, xb_xcc_id(), (volatile LAS unsigned*)(lds + 147200) + 8}; (void)xbar; unsigned char* ws = A.ws; asm volatile("" : "+s"(ws)); float* H = A.out; asm volatile("" : "+s"(H)); \
        bf16* HB = (bf16*)(ws + WS_HB); float* PSQ = (float*)(ws + WS_PSQ); bf16* ACT = (bf16*)(ws + WS_ACT); (void)HB; (void)PSQ; (void)ACT; (void)H;
    volatile LAS unsigned* MISC = (volatile LAS unsigned*)(lds + 147200);
    if (threadIdx.x < 32) MISC[threadIdx.x] = 0u;
    __syncthreads();
    (void)xcd_barrier_post((unsigned*)A_.ws + 4096, MISC + 8);
#ifndef PH_MASK
#define PH_MASK 0xffff
#endif
#define IN(k) ((((PH_MASK >> (k)) & 1) != 0) && opaque_true())
#define SEAM(k) do { if ((((PH_MASK >> (k)) & 3) == 3)) { if ((k) == 0 && !opaque_true()) grid.sync();     \
        { const XcdBarrier xb_{(unsigned*)load_args().ws + 4096, xb_xcc_id(), (volatile LAS unsigned*)(lds + 147200) + 8}; xcd_barrier(xb_, wave); } } } while (0)
#define GEMM_SW(Bt_off, Nn, cjslot) do { pg8::Gemm g{HB, (const pg8::bf16_t*)(ws + (Bt_off)), K::M, (Nn), 1024, 1024}; pg8::StaticOrder S; S.init(K::M, (Nn), G, bx); pg8::EpiSwiGLU E{ACT, PSQ, pg8::CacheJob{A.cache_k, A.cache_v, (bf16*)(ws + WS_KS), (bf16*)(ws + WS_VS), (cjslot)}}; \
        pg8::gemm_phase<pg8::EpiSwiGLU, pg8::StaticOrder, true, true>(lds, g, S, E, wave); } while (0)
#define GEMM_DN(mi, youtp) do { { pg8::Gemm g{ACT, (const pg8::bf16_t*)(ws + WS_WDN + (mi) * WDN_BYTES), K::MP, 1024, K::FF, K::FF}; pg8::StaticOrder S; S.init(K::MP, 1024, G, bx); \
        pg8::EpiResid E{HB, PSQ, 0.5f, (youtp)}; pg8::gemm_phase<pg8::EpiResid, pg8::StaticOrder, true, true>(lds, g, S, E, wave); } \
      { pg8::Gemm g{ACT, (const pg8::bf16_t*)(ws + WS_WDN + (mi) * WDN_BYTES), K::M, 1024, 256, K::FF}; pg8::SliceOrder S; S.init(K::MP / 256, 4, 4, 11, G, bx); \
        pg8::EpiPartial E{(float*)(ws + WS_PART), 0.5f}; pg8::gemm_phase<pg8::EpiPartial, pg8::SliceOrder, true, true>(lds, g, S, E, wave); } } while (0)
#define FIXUP(auxv) do { fixup_sample_rows(A, wave, (auxv)); xcd_barrier(xbar, wave); } while (0)

    if (IN(0)) { PH_LOCALS p0_prologue(A, lds, gw, NGW, lane, wave); }
    SEAM(0);
    if (IN(1)) { PH_LOCALS GEMM_SW(WS_WGU00, K::NGU, 0); }
    SEAM(1);
    if (IN(2)) { PH_LOCALS GEMM_DN(0, (float*)nullptr); }
    SEAM(2);
    if (IN(3)) { PH_LOCALS FIXUP(1); pg8::Gemm g{HB, (const pg8::bf16_t*)(ws + WS_WIN), K::M, K::NIN, 1024, 1024}; pg8::StaticOrder S; S.init(K::M, K::NIN, G, bx);
        pg8::EpiInProj E{(bf16*)(ws + WS_GQ), (bf16*)(ws + WS_GK), (bf16*)(ws + WS_GV), (bf16*)(ws + WS_GR), (float*)(ws + WS_GL), PSQ};
        pg8::gemm_phase<pg8::EpiInProj, pg8::StaticOrder, true, true>(lds, g, S, E, wave); }
    SEAM(3);
    if (IN(4)) { PH_LOCALS
        { PrepIn pin; if (vcu < 2112) gla_prep_load(pin, A, vcu, tid); for (int it = vcu; it < 2112; it += G) gla_prep_item(A, lds, it, tid, pin, it + G); }
        xcd_barrier(xbar, wave);
        for (int it = vcu; it < 256; it += G) gla_scan_item<64>(A, it >> 5, (it >> 3) & 3, it & 7, tid);
        for (int it = vcu; it < 512; it += G) gla_scan_item<1>(A, it >> 5, (it >> 3) & 3, it & 7, tid);
    }
    SEAM(4);
    if (IN(5)) { PH_LOCALS { const int w_ = wave, fr_ = lane & 15, fq_ = lane >> 4; OutB Bc; if (vcu < 2112) gla_out_loadB(Bc, ws, vcu, w_, fr_, fq_); for (int it = vcu; it < 2112; it += G) gla_out_item(A, lds, it, tid, Bc, it + G); } }
    SEAM(5);
    if (IN(6)) { PH_LOCALS pg8::Gemm g{(const pg8::bf16_t*)(ws + WS_OB), (const pg8::bf16_t*)(ws + WS_WOA), K::M, 1024, 1024, 1024}; pg8::StaticOrder S; S.init(K::M, 1024, G, bx);
        pg8::EpiResid E{HB, PSQ, 1.0f, (float*)nullptr}; pg8::gemm_phase<pg8::EpiResid, pg8::StaticOrder, true, true>(lds, g, S, E, wave); }
    SEAM(6);
    if (IN(7)) { PH_LOCALS GEMM_SW(WS_WGU01, K::NGU, 1); }
    SEAM(7);
    if (IN(8)) { PH_LOCALS GEMM_DN(1, (float*)nullptr); }
    SEAM(8);
    if (IN(9)) { PH_LOCALS FIXUP(1); pg8::Gemm g{HB, (const pg8::bf16_t*)(ws + WS_WKVF), K::M, K::NCAT, 1024, 1024}; pg8::StaticOrder S; S.init(K::M, K::NCAT, G, bx);
        pg8::EpiCat E{A.out, (bf16*)(ws + WS_KP), (bf16*)(ws + WS_VP), (bf16*)(ws + WS_KS), (bf16*)(ws + WS_VS), A.g_k, A.b_f, PSQ, ACT, pg8::CacheJob{A.cache_k, A.cache_v, (bf16*)(ws + WS_KS), (bf16*)(ws + WS_VS), 2}};
        pg8::gemm_phase<pg8::EpiCat, pg8::StaticOrder, true, true>(lds, g, S, E, wave); }
    SEAM(9);
    if (IN(10)) { PH_LOCALS logf_cumsum(A, vcu, wave, G, lane); GEMM_DN(2, (float*)nullptr); }
    SEAM(10);
    if (IN(11)) { PH_LOCALS FIXUP(1); pg8::Gemm g{HB, (const pg8::bf16_t*)(ws + WS_WQG), K::M, K::NQG, 1024, 1024}; pg8::StaticOrder S; S.init(K::M, K::NQG, G, bx);
        pg8::EpiQG E{(bf16*)(ws + WS_QP), (bf16*)(ws + WS_GATE), A.b_g_q, PSQ};
        pg8::gemm_phase<pg8::EpiQG, pg8::StaticOrder, true, true>(lds, g, S, E, wave); }
    SEAM(11);
    if (IN(12)) { PH_LOCALS
        typedef attn_body::bf16 abf; char* shm = (char*)lds_raw;
        for (int v = vcu; v < 256; v += G) {
            for (int i = 0; i < 9; ++i) {
                unsigned char* wl = ws; asm volatile("" : "+s"(wl));
                const abf *Qu, *Kh, *Vh; const float* cn; int nt; unsigned stm;
                if (i < 8) { const int bh = v >> 1, b = bh >> 4, h = bh & 15; const int s = 4 * (v & 1) + (i >> 1); const int qb = (i & 1) ? 15 - s : s;
                    const size_t r0 = (size_t)b * K::SEQ + qb * 256, ro = r0 * 1024 + h * 64, kb0 = (size_t)b * K::SEQ * 1024 + h * 64;
                    Qu = (const abf*)(wl + WS_QP) + ro; Kh = (const abf*)(wl + WS_KP) + kb0; Vh = (const abf*)(wl + WS_VP) + kb0; cn = (const float*)(wl + WS_CP) + (size_t)bh * K::SEQ; nt = 4 * (qb + 1); stm = 0xffu; }
                else { const int sb = v >> 4, sh = v & 15;
                    const size_t ro = ((size_t)K::MP + sb * 64) * 1024 + sh * 64, kb0 = (size_t)sb * K::SKR * 1024 + sh * 64;
                    Qu = (const abf*)(wl + WS_QP) + ro; Kh = (const abf*)(wl + WS_KS) + kb0; Vh = (const abf*)(wl + WS_VS) + kb0; cn = (const float*)(wl + WS_CS) + (size_t)(sb * 16 + sh) * K::SKR; nt = 68; stm = 0x3u; }
                attn_body::attn_unit<8>(Qu, Kh, Vh, (long)((WS_AO - WS_QP) / 2), (long)((WS_GATE - WS_QP) / 2), cn, nt, stm, shm, wave);
            }
        }
    }
    SEAM(12);
    if (IN(13)) { PH_LOCALS pg8::Gemm g{(const pg8::bf16_t*)(ws + WS_AO), (const pg8::bf16_t*)(ws + WS_WOB), K::M, 1024, 1024, 1024}; pg8::StaticOrder S; S.init(K::M, 1024, G, bx);
        pg8::EpiResid E{HB, PSQ, 1.0f, (float*)nullptr}; pg8::gemm_phase<pg8::EpiResid, pg8::StaticOrder, true, true>(lds, g, S, E, wave); }
    SEAM(13);
    if (IN(14)) { PH_LOCALS GEMM_SW(WS_WGU11, K::NGU, -1); }
    SEAM(14);
    if (IN(15)) { PH_LOCALS GEMM_DN(3, H); xcd_barrier(xbar, wave); fixup_sample_rows(A, wave, 0); }
#undef IN
#undef SEAM
}

#ifndef MK_MULTI
#define MK_MULTI 0
#endif
extern "C" void kernel_launch(void* const* d_in, const int* in_sizes, int n_in, void* d_out, int out_size, void* d_ws, size_t ws_size, hipStream_t stream) {
    static int grid = 0;
    if (grid == 0) {
        if (n_in != 22 || (size_t)out_size != K::O_TOTAL || ws_size < WS_END) { fprintf(stderr, "kernel_launch: unexpected shapes (n_in %d out %d ws %zu)\n", n_in, out_size, ws_size); grid = -1; return; }
        int dev = 0, cus = 0, per_cu = 0;
        hipGetDevice(&dev); hipDeviceGetAttribute(&cus, hipDeviceAttributeMultiprocessorCount, dev);
        if (hipFuncSetAttribute((const void*)mega_fwd, hipFuncAttributeMaxDynamicSharedMemorySize, LDS_BYTES) != hipSuccess) { fprintf(stderr, "hipFuncSetAttribute failed\n"); grid = -1; return; }
        if (hipOccupancyMaxActiveBlocksPerMultiprocessor(&per_cu, (const void*)mega_fwd, NTHREADS, LDS_BYTES) != hipSuccess || per_cu < 1) { fprintf(stderr, "occupancy query: %d\n", per_cu); per_cu = 1; }
        (void)hipGetLastError();
        grid = cus * 1;
        if (grid > 256) grid = 256;
    }
    if (grid < 0) return;
    if (hipMemsetAsync(d_ws, 0, 1u << 20, stream) != hipSuccess) { fprintf(stderr, "memset failed\n"); return; }
    Args a{};
    const float** p = (const float**)&a;
    for (int i = 0; i < 22; ++i) p[i] = (const float*)d_in[i];
    a.out = (float*)d_out; a.ws = (unsigned char*)d_ws;
    void* args[] = {&a};
    hipError_t e = hipLaunchCooperativeKernel((const void*)mega_fwd, dim3(grid), dim3(NTHREADS), args, LDS_BYTES, stream);
    if (e != hipSuccess) fprintf(stderr, "cooperative launch failed: %s (grid %d)\n", hipGetErrorString(e), grid);
}
```

```cpp
#include <hip/hip_runtime.h>
#include <hip/hip_cooperative_groups.h>
#include <hip/hip_bf16.h>
#include <cstdio>
#include <cstdint>
#include <cmath>
namespace cg = cooperative_groups;
namespace K {
constexpr int D = 1024, MP = 32768, MS = 1024, M = MP + MS, FF = 2816, NGU = 5632, NIN = 3328, NIN_SRC = 3088, NKVF = 2304, NKVF_SRC = 2064, NQG = 2048, NCAT = NKVF + NGU;
constexpr int SEQ = 4096, PAST = 4096, SKR = 4352  ;
constexpr float EPS = 1e-6f, LOG2E = 1.4426950408889634f, LN2 = 0.6931471805599453f;
constexpr float C2 = 0.125f * 1.4426950408889634f;
constexpr size_t O_Y = 0, O_GLAP = 34603008, O_GLAS = 35651584, O_KP = 37748736, O_VP = 71303168, O_LFP = 104857600, O_KS = 105381888, O_VS = 106430464, O_LFS = 107479040, O_TOTAL = 107495424;
}

__device__ __forceinline__ int lane_id_() { unsigned z = 0u; asm volatile("" : "+v"(z)); return (int)__builtin_amdgcn_mbcnt_hi(~0u, __builtin_amdgcn_mbcnt_lo(~0u, z)); }

namespace pg8 {
#define PG8_LAS __attribute__((address_space(3)))
typedef unsigned short bf16_t;
typedef short bf16x8 __attribute__((ext_vector_type(8)));
typedef float f32x4 __attribute__((ext_vector_type(4)));
typedef unsigned u32x4 __attribute__((ext_vector_type(4)));
constexpr int BM = 256, BK = 64, HALF = 128, HTB = HALF * BK * 2  , STAGE_BYTES = 8 * HTB, NXCD = 8, WGM = 8;

__host__ __device__ __forceinline__ int lds_byte(int r, int c) { const int st = (r >> 4) * 2 + (c >> 5), rr = r & 15, cc = c & 31, ob = rr * 64 + cc * 2; return st * 1024 + (ob ^ (((ob >> 9) & 1) << 5)); }
__host__ __device__ __forceinline__ void stage_rc(int b, int& R, int& C) { const int st = b / 1024, sb = b % 1024, swz = sb ^ (((sb >> 9) & 1) << 5); R = (st >> 1) * 16 + swz / 64; C = (st & 1) * 32 + (swz % 64) / 2; }
__host__ __device__ __forceinline__ int perm32(int rho) { const int n = rho >> 4, i = rho & 15; return 8 * (i >> 2) + 4 * n + (i & 3); }

struct Unit { int pm, pn, ks; };
struct Gemm { const bf16_t* A; const bf16_t* Bt; int M, N, K, ld; };

struct StaticOrder {
    int nM, nN, nwg, G, c;
    __host__ __device__ void init(int M, int N, int G_, int c_) { nM = M / BM; nN = N / BM; nwg = nM * nN; G = G_; c = c_; }
    __host__ __device__ bool next(int i, Unit& u) const {
        const long L = (long)i * G + c; if (L >= nwg) return false;
        int wgid = (int)L; { const int q = nwg / NXCD, r = nwg % NXCD, xcd = wgid % NXCD, off = wgid / NXCD; wgid = (xcd < r ? xcd * (q + 1) : r * (q + 1) + (xcd - r) * q) + off; }
        const int nig = WGM * nN, gid = wgid / nig, fm = gid * WGM, gsz = (nM - fm) < WGM ? (nM - fm) : WGM;
        u.pm = fm + ((wgid % nig) % gsz); u.pn = (wgid % nig) / gsz; u.ks = 0; return true;
    }
    __device__ __forceinline__ void a_ready(const Unit&) const {}
    __device__ __forceinline__ void done(const Unit&) const {}
};

__device__ __forceinline__ unsigned cvt_pk_bf16(float lo, float hi) { unsigned r; asm volatile("v_cvt_pk_bf16_f32 %0, %1, %2" : "=v"(r) : "v"(lo), "v"(hi)); return r; }
typedef float f32x2 __attribute__((ext_vector_type(2)));
struct SliceOrder {
    int pm0, nN, P, nun, G, c;
    __host__ __device__ void init(int pm0_, int nM, int nN_, int P_, int G_, int c_) { pm0 = pm0_; nN = nN_; P = P_; nun = nM * nN_ * P_; G = G_; c = c_; }
    __host__ __device__ bool next(int i, Unit& u) const { const long L = (long)i * G + c; if (L >= nun) return false; const int t = (int)L / P; u.ks = (int)L % P; u.pm = pm0 + t / nN; u.pn = t % nN; return true; }
    __device__ __forceinline__ void a_ready(const Unit&) const {}
    __device__ __forceinline__ void done(const Unit&) const {}
};

#define GASP __attribute__((address_space(1)))
__device__ __forceinline__ float fast_sigmoid(float x) { return __builtin_amdgcn_rcpf(1.0f + __builtin_amdgcn_exp2f(-x * K::LOG2E)); }
__device__ __forceinline__ float logsigmoid_f(float z) { return fminf(z, 0.f) - K::LN2 * __builtin_amdgcn_logf(1.0f + __builtin_amdgcn_exp2f(-fabsf(z) * K::LOG2E)); }
typedef float f32x2v __attribute__((ext_vector_type(2))); typedef __bf16 bf16x2v __attribute__((ext_vector_type(2)));
__device__ __forceinline__ unsigned pkbf(float lo, float hi) { f32x2v v = {lo, hi}; bf16x2v b = __builtin_convertvector(v, bf16x2v); return __builtin_bit_cast(unsigned, b); }
__device__ __forceinline__ u32x4 pk8(const f32x4 a, const f32x4 b) { u32x4 w; w.x = pkbf(a[0], a[1]); w.y = pkbf(a[2], a[3]); w.z = pkbf(b[0], b[1]); w.w = pkbf(b[2], b[3]); return w; }
__device__ __forceinline__ float row_rstd(const float* psq, int row, int fq) {
    const f32x4 p = *(const GASP f32x4*)(psq + (size_t)row * 16 + 4 * fq);
    float s = (p[0] + p[1]) + (p[2] + p[3]);
    s += __shfl_xor(s, 16); s += __shfl_xor(s, 32);
    return __builtin_amdgcn_rsqf(s * (1.0f / 1024.0f) + K::EPS);
}
#define ACC_T const f32x4 (&acc)[2][2][4][2]
struct CacheJob { const float* ck; const float* cv; bf16_t* ks; bf16_t* vs; int slot; };
constexpr long CJ_NVEC = (long)16 * K::PAST * 1024 / 8;
__device__ __forceinline__ void cj_load(const CacheJob& J, int uid, int tid, f32x4 (&a0)[4], f32x4 (&a1)[4]) {
#pragma unroll
    for (int j = 0; j < 4; ++j) { const long v = (long)uid * 2048 + j * 512 + tid; if (v < 2 * CJ_NVEC) { const bool isv = v >= CJ_NVEC; const float* src = (isv ? J.cv : J.ck) + (size_t)(isv ? v - CJ_NVEC : v) * 8;
            a0[j] = __builtin_nontemporal_load((const GASP f32x4*)src); a1[j] = __builtin_nontemporal_load((const GASP f32x4*)(src + 4)); } }
}
__device__ __forceinline__ void cj_store(const CacheJob& J, int uid, int tid, const f32x4 (&a0)[4], const f32x4 (&a1)[4]) {
#pragma unroll
    for (int j = 0; j < 4; ++j) { const long v = (long)uid * 2048 + j * 512 + tid; if (v < 2 * CJ_NVEC) { const bool isv = v >= CJ_NVEC; const size_t el = (size_t)(isv ? v - CJ_NVEC : v) * 8, b = el / ((size_t)K::PAST * 1024), rem = el - b * (size_t)K::PAST * 1024;
            *(GASP u32x4*)((isv ? J.vs : J.ks) + b * (size_t)K::SKR * 1024 + rem) = pk8(a0[j], a1[j]); } }
}
__device__ __forceinline__ void epi_swiglu(ACC_T, int pm, int pnl, int wr, int wc, int fr, int fq, bf16_t* act, const float* psq, const CacheJob& J) {
    const int tid_ = (wr * 4 + wc) * 64 + fq * 16 + fr, uid_ = J.slot * 2904 + pm * 22 + pnl; f32x4 cj0[4], cj1[4];
    float rsv[2][4];
#pragma unroll
    for (int ai = 0; ai < 2; ++ai)
#pragma unroll
        for (int m = 0; m < 4; ++m) rsv[ai][m] = row_rstd(psq, pm * BM + ai * HALF + wr * 64 + m * 16 + fr, fq);
    asm volatile("" ::: "memory");
    if (J.slot >= 0) cj_load(J, uid_, tid_, cj0, cj1);
#pragma unroll
    for (int ai = 0; ai < 2; ++ai)
#pragma unroll
        for (int m = 0; m < 4; ++m) {
            const int row = pm * BM + ai * HALF + wr * 64 + m * 16 + fr; const float rs = rsv[ai][m];
            f32x4 o[2];
#pragma unroll
            for (int n = 0; n < 2; ++n) { const f32x4 g = acc[ai][0][m][n] * rs, u = acc[ai][1][m][n] * rs;
#pragma unroll
                for (int j = 0; j < 4; ++j) o[n][j] = g[j] * fast_sigmoid(g[j]) * u[j]; }
            __builtin_nontemporal_store(pk8(o[0], o[1]), (GASP u32x4*)(act + (size_t)row * K::FF + pnl * 128 + wc * 32 + 8 * fq));
        }
    if (J.slot >= 0) cj_store(J, uid_, tid_, cj0, cj1);
}
struct EpiSwiGLU { static constexpr bool PERM = true, AFTER_DRAIN = false; bf16_t* act; const float* psq; CacheJob J;
    __device__ __forceinline__ void operator()(ACC_T, const Unit& u, int wr, int wc, int fr, int fq) const { epi_swiglu(acc, u.pm, u.pn, wr, wc, fr, fq, act, psq, J); } };
struct EpiResid { static constexpr bool PERM = true, AFTER_DRAIN = false;
    bf16_t* hb; float* psq; float scale; float* yout;
    __device__ __forceinline__ void operator()(ACC_T, const Unit& u, int wr, int wc, int fr, int fq) const {
#pragma unroll
        for (int ai = 0; ai < 2; ++ai)
#pragma unroll
            for (int m = 0; m < 4; ++m) {
                const int row = u.pm * BM + ai * HALF + wr * 64 + m * 16 + fr; const size_t off = (size_t)row * K::D + u.pn * BM + wc * 32 + 8 * fq; float ss = 0.f;
#pragma unroll
                for (int bj = 0; bj < 2; ++bj) {
                    const u32x4 hw = *(const GASP u32x4*)(hb + off + bj * HALF);
                    f32x4 v0, v1;
                    v0[0] = __uint_as_float(hw.x << 16); v0[1] = __uint_as_float(hw.x & 0xffff0000u); v0[2] = __uint_as_float(hw.y << 16); v0[3] = __uint_as_float(hw.y & 0xffff0000u);
                    v1[0] = __uint_as_float(hw.z << 16); v1[1] = __uint_as_float(hw.z & 0xffff0000u); v1[2] = __uint_as_float(hw.w << 16); v1[3] = __uint_as_float(hw.w & 0xffff0000u);
                    v0 = v0 + acc[ai][bj][m][0] * scale; v1 = v1 + acc[ai][bj][m][1] * scale;
                    if (yout) { *(GASP f32x4*)(yout + off + bj * HALF) = v0; *(GASP f32x4*)(yout + off + bj * HALF + 4) = v1; }
                    else { ss += (v0[0] * v0[0] + v0[1] * v0[1]) + (v0[2] * v0[2] + v0[3] * v0[3]) + (v1[0] * v1[0] + v1[1] * v1[1]) + (v1[2] * v1[2] + v1[3] * v1[3]);
                        *(GASP u32x4*)(hb + off + bj * HALF) = pk8(v0, v1); }
                }
                if (!yout) { ss += __shfl_xor(ss, 16); ss += __shfl_xor(ss, 32);
                    if (fq == 0) *(GASP float*)(psq + (size_t)row * 16 + u.pn * 4 + wc) = ss; }
                asm volatile("" ::: "memory");
            }
    }
};
struct EpiInProj { static constexpr bool PERM = true, AFTER_DRAIN = false;
    bf16_t* q; bf16_t* k; bf16_t* v; bf16_t* rs_; float* gl; const float* psq;
    __device__ __forceinline__ void operator()(ACC_T, const Unit& u, int wr, int wc, int fr, int fq) const {
        const int pn = u.pn;
#pragma unroll
        for (int ai = 0; ai < 2; ++ai)
#pragma unroll
            for (int m = 0; m < 4; ++m) {
                const int row = u.pm * BM + ai * HALF + wr * 64 + m * 16 + fr; const float rs = row_rstd(psq, row, fq);
                const int c = wc * 32 + 8 * fq;
                if (pn < 4) { bf16_t* dst = (pn < 2 ? q : k) + (size_t)row * 512 + (pn & 1) * 256 + c; const float s = pn < 2 ? rs * 0.08838834764831845f : rs;
#pragma unroll
                    for (int bj = 0; bj < 2; ++bj) *(GASP u32x4*)(dst + bj * HALF) = pk8(acc[ai][bj][m][0] * s, acc[ai][bj][m][1] * s);
                } else if (pn < 8) { bf16_t* dst = v + (size_t)row * 1024 + (pn - 4) * 256 + c;
#pragma unroll
                    for (int bj = 0; bj < 2; ++bj) *(GASP u32x4*)(dst + bj * HALF) = pk8(acc[ai][bj][m][0] * rs, acc[ai][bj][m][1] * rs);
                } else if (pn < 12) { bf16_t* dst = rs_ + (size_t)row * 1024 + (pn - 8) * 256 + c;
#pragma unroll
                    for (int bj = 0; bj < 2; ++bj) { f32x4 a = acc[ai][bj][m][0] * rs, b = acc[ai][bj][m][1] * rs;
#pragma unroll
                        for (int j = 0; j < 4; ++j) { a[j] = a[j] * fast_sigmoid(a[j]); b[j] = b[j] * fast_sigmoid(b[j]); }
                        *(GASP u32x4*)(dst + bj * HALF) = pk8(a, b); }
                } else { if (wc == 0 && fq < 2) { float* dst = gl + (size_t)row * 16 + 8 * fq; *(f32x4*)dst = acc[ai][0][m][0] * rs; *(GASP f32x4*)(dst + 4) = acc[ai][0][m][1] * rs; } }
            }
    }
};
struct EpiCat { static constexpr bool PERM = true, AFTER_DRAIN = false;
    float* dout; bf16_t* kp; bf16_t* vp; bf16_t* ks; bf16_t* vs; const float* g_k; const float* b_f; const float* psq; bf16_t* act; CacheJob J;
    __device__ __forceinline__ void operator()(ACC_T, const Unit& u, int wr, int wc, int fr, int fq) const {
        const int pn = u.pn;
        if (pn >= 9) { epi_swiglu(acc, u.pm, pn - 9, wr, wc, fr, fq, act, psq, J); return; }
        const bool samp = u.pm >= K::MP / BM;
#pragma unroll
        for (int ai = 0; ai < 2; ++ai)
#pragma unroll
            for (int m = 0; m < 4; ++m) {
                const int row = u.pm * BM + ai * HALF + wr * 64 + m * 16 + fr; const float rs = row_rstd(psq, row, fq);
                if (pn < 8) {
                    const int head = (pn & 3) * 4 + wc; const bool isk = pn < 4;
                    f32x4 x[2][2]; float ss = 0.f;
#pragma unroll
                    for (int bj = 0; bj < 2; ++bj)
#pragma unroll
                        for (int n = 0; n < 2; ++n) { x[bj][n] = acc[ai][bj][m][n] * rs; ss += (x[bj][n][0] * x[bj][n][0] + x[bj][n][1] * x[bj][n][1]) + (x[bj][n][2] * x[bj][n][2] + x[bj][n][3] * x[bj][n][3]); }
                    ss += __shfl_xor(ss, 16); ss += __shfl_xor(ss, 32);
                    const float rk = isk ? __builtin_amdgcn_rsqf(ss * (1.0f / 64.0f) + K::EPS) : 1.0f;
                    float* fo; bf16_t* bo;
                    if (!samp) { fo = dout + (isk ? K::O_KP : K::O_VP) + (size_t)row * 1024; bo = (isk ? kp : vp) + (size_t)row * 1024; }
                    else { const int sr = row - K::MP; fo = dout + (isk ? K::O_KS : K::O_VS) + (size_t)sr * 1024; bo = (isk ? ks : vs) + ((size_t)(sr >> 6) * K::SKR + K::PAST + (sr & 63)) * 1024; }
#pragma unroll
                    for (int bj = 0; bj < 2; ++bj) { const int hc = 32 * bj + 8 * fq; f32x4 a = x[bj][0] * rk, b = x[bj][1] * rk;
                        if (isk) { a = a * *(const GASP f32x4*)(g_k + hc); b = b * *(const GASP f32x4*)(g_k + hc + 4); }
                        __builtin_nontemporal_store(a, (GASP f32x4*)(fo + head * 64 + hc)); __builtin_nontemporal_store(b, (GASP f32x4*)(fo + head * 64 + hc + 4)); *(GASP u32x4*)(bo + head * 64 + hc) = pk8(a, b); }
                } else {
                    if (wc == 0 && fq < 2) { float* fo = samp ? dout + K::O_LFS + (size_t)(row - K::MP) * 16 : dout + K::O_LFP + (size_t)row * 16;
                        f32x4 a = acc[ai][0][m][0] * rs + *(const GASP f32x4*)(b_f + 8 * fq), b = acc[ai][0][m][1] * rs + *(const GASP f32x4*)(b_f + 8 * fq + 4);
#pragma unroll
                        for (int j = 0; j < 4; ++j) { a[j] = logsigmoid_f(a[j]); b[j] = logsigmoid_f(b[j]); }
                        *(GASP f32x4*)(fo + 8 * fq) = a; *(GASP f32x4*)(fo + 8 * fq + 4) = b; }
                }
            }
    }
};
struct EpiQG { static constexpr bool PERM = true, AFTER_DRAIN = false;
    bf16_t* qp; bf16_t* gate; const float* g_q; const float* psq;
    __device__ __forceinline__ void operator()(ACC_T, const Unit& u, int wr, int wc, int fr, int fq) const {
        const int pn = u.pn; const int head = (pn & 3) * 4 + wc; const bool isq = pn < 4;
#pragma unroll
        for (int ai = 0; ai < 2; ++ai)
#pragma unroll
            for (int m = 0; m < 4; ++m) {
                const int row = u.pm * BM + ai * HALF + wr * 64 + m * 16 + fr; const float rs = row_rstd(psq, row, fq);
                f32x4 x[2][2]; float ss = 0.f;
#pragma unroll
                for (int bj = 0; bj < 2; ++bj)
#pragma unroll
                    for (int n = 0; n < 2; ++n) { x[bj][n] = acc[ai][bj][m][n] * rs; ss += (x[bj][n][0] * x[bj][n][0] + x[bj][n][1] * x[bj][n][1]) + (x[bj][n][2] * x[bj][n][2] + x[bj][n][3] * x[bj][n][3]); }
                ss += __shfl_xor(ss, 16); ss += __shfl_xor(ss, 32);
                bf16_t* bo;
                bo = (isq ? qp : gate) + (size_t)row * 1024;
                const float rq = __builtin_amdgcn_rsqf(ss * (1.0f / 64.0f) + K::EPS) * K::C2;
#pragma unroll
                for (int bj = 0; bj < 2; ++bj) { const int hc = 32 * bj + 8 * fq; f32x4 a, b;
                    if (isq) { a = x[bj][0] * rq * *(const GASP f32x4*)(g_q + hc); b = x[bj][1] * rq * *(const GASP f32x4*)(g_q + hc + 4); }
                    else {
#pragma unroll
                        for (int j = 0; j < 4; ++j) { a[j] = fast_sigmoid(x[bj][0][j]); b[j] = fast_sigmoid(x[bj][1][j]); } }
                    *(GASP u32x4*)(bo + head * 64 + hc) = pk8(a, b); }
            }
    }
};
struct EpiPartial { static constexpr bool PERM = true, AFTER_DRAIN = false; float* part; float scale;
    __device__ __forceinline__ void operator()(ACC_T, const Unit& u, int wr, int wc, int fr, int fq) const {
        float* base = part + (size_t)u.ks * (K::MS * 1024);
#pragma unroll
        for (int ai = 0; ai < 2; ++ai)
#pragma unroll
            for (int m = 0; m < 4; ++m) { const int row = u.pm * BM + ai * HALF + wr * 64 + m * 16 + fr - K::MP; const size_t off = (size_t)row * K::D + u.pn * BM + wc * 32 + 8 * fq;
#pragma unroll
                for (int bj = 0; bj < 2; ++bj) { *(GASP f32x4*)(base + off + bj * HALF) = acc[ai][bj][m][0] * scale; *(GASP f32x4*)(base + off + bj * HALF + 4) = acc[ai][bj][m][1] * scale; } }
    }
};
#undef ACC_T

template <class Epi, class Sched, bool ALIGN_EPI = false, bool SP2 = false>
__device__ __forceinline__ void gemm_phase(PG8_LAS unsigned char* lds, const Gemm g, const Sched& S, const Epi& E, const int wv) {
    const int lane = lane_id_(), wid = wv, tid = wv * 64 + lane, wr = wid >> 2, wc = wid & 3, fr = lane & 15, fq = lane >> 4;
    const int K = g.ld, nt = g.K / BK;
    unsigned voffA[2], voffB[2];
#pragma unroll
    for (int i = 0; i < 2; ++i) { int R, C; stage_rc(tid * 16 + i * 8192, R, C); const int Rb = Epi::PERM ? ((R & ~31) + perm32(R & 31)) : R;
        voffA[i] = (unsigned)(R * K + C) * 2u; voffB[i] = (unsigned)(Rb * K + C) * 2u; }
    const size_t kstep = (size_t)(BK * 2);
    const size_t hstep = (size_t)HALF * K * 2;
    const size_t tstep = 2 * hstep;
    const unsigned ldsw = (unsigned)wid * 1024u;
    const int aoff = lds_byte(wr * 64 + fr, fq * 8), boff = lds_byte(wc * 32 + fr, fq * 8);
#define PG8_SA(b, h) (((b) * 2 + (h)) * HTB)
#define PG8_SB(b, h) ((4 + (b) * 2 + (h)) * HTB)
#define PG8_STAGE(bufoff, gbase, voff) do { _Pragma("unroll") for (int _i = 0; _i < 2; ++_i) \
        __builtin_amdgcn_global_load_lds((const unsigned*)((const char*)(gbase) + (voff)[_i]), (PG8_LAS unsigned*)(lds + (bufoff) + ldsw + _i * 8192), 16, 0, 0); } while (0)
#define PG8_LDA(dst, b, h) do { _Pragma("unroll") for (int m = 0; m < 4; ++m) _Pragma("unroll") for (int k = 0; k < 2; ++k) dst[m][k] = *(const PG8_LAS bf16x8*)(lds + PG8_SA(b, h) + aoff + m * 2048 + k * 1024); } while (0)
#define PG8_LDB(dst, b, h) do { _Pragma("unroll") for (int n = 0; n < 2; ++n) _Pragma("unroll") for (int k = 0; k < 2; ++k) dst[n][k] = *(const PG8_LAS bf16x8*)(lds + PG8_SB(b, h) + boff + n * 2048 + k * 1024); } while (0)
#define PG8_MMA(ai, bj, At, Bt) do { __builtin_amdgcn_s_setprio(1); _Pragma("unroll") for (int m = 0; m < 4; ++m) _Pragma("unroll") for (int n = 0; n < 2; ++n) _Pragma("unroll") for (int k = 0; k < 2; ++k) \
        acc[ai][bj][m][n] = __builtin_amdgcn_mfma_f32_16x16x32_bf16(Bt[n][k], At[m][k], acc[ai][bj][m][n], 0, 0, 0); __builtin_amdgcn_s_setprio(0); } while (0)
#define PG8_WAIT_V(n) asm volatile("s_waitcnt vmcnt(" #n ")" ::: "memory")
#define PG8_WAIT_L(n) asm volatile("s_waitcnt lgkmcnt(" #n ")" ::: "memory")
#define PG8_BAR __builtin_amdgcn_s_barrier()
#define PG8_SCHED __builtin_amdgcn_sched_barrier(0)
    Unit cur, nxt; int ui = 0;
    if (!S.next(0, cur)) return;
    f32x4 acc[2][2][4][2];
#pragma unroll
    for (int a = 0; a < 2; ++a)
#pragma unroll
        for (int b = 0; b < 2; ++b)
#pragma unroll
            for (int m = 0; m < 4; ++m)
#pragma unroll
                for (int n = 0; n < 2; ++n) acc[a][b][m][n] = (f32x4){0.f, 0.f, 0.f, 0.f};
    bf16x8 At[4][2], B0[2][2], B1[2][2];
    const size_t sstep = (size_t)g.K * 2;
    const char* cA = (const char*)g.A + (size_t)cur.pm * tstep + (size_t)cur.ks * sstep; const char* cB = (const char*)g.Bt + (size_t)cur.pn * tstep + (size_t)cur.ks * sstep;
    S.a_ready(cur);
    if constexpr (SP2) {
        PG8_STAGE(PG8_SB(0, 0), cB, voffB); PG8_STAGE(PG8_SB(0, 1), cB + hstep, voffB); PG8_STAGE(PG8_SA(0, 0), cA, voffA); PG8_STAGE(PG8_SA(0, 1), cA + hstep, voffA);
        if (wr == 1) PG8_BAR;
        PG8_WAIT_V(2); PG8_BAR;
        PG8_STAGE(PG8_SB(1, 0), cB + kstep, voffB); PG8_STAGE(PG8_SA(1, 0), cA + kstep, voffA); PG8_STAGE(PG8_SB(1, 1), cB + hstep + kstep, voffB);
        PG8_WAIT_V(6); PG8_BAR;
    } else {
        PG8_STAGE(PG8_SB(0, 0), cB, voffB); PG8_STAGE(PG8_SA(0, 0), cA, voffA); PG8_STAGE(PG8_SB(0, 1), cB + hstep, voffB); PG8_STAGE(PG8_SA(0, 1), cA + hstep, voffA);
        if (wr == 1) PG8_BAR;
        PG8_WAIT_V(4); PG8_BAR;
        PG8_STAGE(PG8_SB(1, 0), cB + kstep, voffB); PG8_STAGE(PG8_SA(1, 0), cA + kstep, voffA); PG8_STAGE(PG8_SB(1, 1), cB + hstep + kstep, voffB);
        PG8_WAIT_V(6); PG8_BAR;
    }
    for (;;) {
        const bool has_next = S.next(ui + 1, nxt);
        const char* nA = has_next ? (const char*)g.A + (size_t)nxt.pm * tstep + (size_t)nxt.ks * sstep : cA; const char* nB = has_next ? (const char*)g.Bt + (size_t)nxt.pn * tstep + (size_t)nxt.ks * sstep : cB;
        for (int t = 0; t < nt; t += 2) {
            const bool last = (t == nt - 2);
            const char* a1 = cA + (size_t)(t + 1) * kstep;
            const char* a2 = last ? nA : cA + (size_t)(t + 2) * kstep; const char* b2 = last ? nB : cB + (size_t)(t + 2) * kstep;
            const char* a3 = a2 + kstep; const char* b3 = b2 + kstep;
            if (last && has_next) S.a_ready(nxt);
            if constexpr (SP2) {
            PG8_LDB(B0, 0, 0); PG8_LDB(B1, 0, 1); PG8_SCHED; PG8_LDA(At, 0, 0); PG8_STAGE(PG8_SA(1, 1), a1 + hstep, voffA);
            PG8_WAIT_V(8); PG8_WAIT_L(0); PG8_BAR; PG8_MMA(0, 0, At, B0); PG8_MMA(0, 1, At, B1); PG8_BAR; PG8_SCHED;
            PG8_LDA(At, 0, 1); PG8_STAGE(PG8_SB(0, 0), b2, voffB); PG8_STAGE(PG8_SB(0, 1), b2 + hstep, voffB); PG8_STAGE(PG8_SA(0, 0), a2, voffA);
            PG8_WAIT_V(8); PG8_WAIT_L(0); PG8_BAR; PG8_MMA(1, 0, At, B0); PG8_MMA(1, 1, At, B1); PG8_BAR; PG8_SCHED;
            PG8_LDB(B0, 1, 0); PG8_LDB(B1, 1, 1); PG8_SCHED; PG8_LDA(At, 1, 0); PG8_STAGE(PG8_SA(0, 1), a2 + hstep, voffA);
            PG8_WAIT_V(8); PG8_WAIT_L(0); PG8_BAR; PG8_MMA(0, 0, At, B0); PG8_MMA(0, 1, At, B1); PG8_BAR; PG8_SCHED;
            PG8_LDA(At, 1, 1); PG8_STAGE(PG8_SB(1, 0), b3, voffB); PG8_STAGE(PG8_SB(1, 1), b3 + hstep, voffB); PG8_STAGE(PG8_SA(1, 0), a3, voffA);
            PG8_WAIT_V(8); PG8_WAIT_L(0); PG8_BAR; PG8_MMA(1, 0, At, B0); PG8_MMA(1, 1, At, B1); PG8_BAR; PG8_SCHED;
            } else {
            PG8_LDB(B0, 0, 0); PG8_SCHED; PG8_LDA(At, 0, 0); PG8_STAGE(PG8_SA(1, 1), a1 + hstep, voffA);
            PG8_WAIT_L(8); PG8_BAR; PG8_WAIT_L(0); PG8_MMA(0, 0, At, B0); PG8_BAR; PG8_SCHED;
            PG8_LDB(B1, 0, 1); PG8_STAGE(PG8_SB(0, 0), b2, voffB);
            PG8_BAR; PG8_WAIT_L(0); PG8_MMA(0, 1, At, B1); PG8_BAR;
            PG8_LDA(At, 0, 1); PG8_STAGE(PG8_SA(0, 0), a2, voffA);
            PG8_BAR; PG8_WAIT_L(0); PG8_MMA(1, 0, At, B0); PG8_BAR; PG8_SCHED;
            PG8_STAGE(PG8_SB(0, 1), b2 + hstep, voffB);
            PG8_WAIT_V(6); PG8_BAR; PG8_MMA(1, 1, At, B1); PG8_BAR;
            PG8_LDB(B0, 1, 0); PG8_SCHED; PG8_LDA(At, 1, 0); PG8_STAGE(PG8_SA(0, 1), a2 + hstep, voffA);
            PG8_WAIT_L(8); PG8_BAR; PG8_WAIT_L(0); PG8_MMA(0, 0, At, B0); PG8_BAR; PG8_SCHED;
            PG8_LDB(B1, 1, 1); PG8_STAGE(PG8_SB(1, 0), b3, voffB);
            PG8_BAR; PG8_WAIT_L(0); PG8_MMA(0, 1, At, B1); PG8_BAR;
            PG8_LDA(At, 1, 1); PG8_STAGE(PG8_SA(1, 0), a3, voffA);
            PG8_BAR; PG8_WAIT_L(0); PG8_MMA(1, 0, At, B0); PG8_BAR; PG8_SCHED;
            PG8_STAGE(PG8_SB(1, 1), b3 + hstep, voffB);
            PG8_WAIT_V(6); PG8_BAR; PG8_MMA(1, 1, At, B1); PG8_BAR;
            }
        }
        if constexpr (ALIGN_EPI) { if (wr == 0) PG8_BAR; }
        if constexpr (!Epi::AFTER_DRAIN) { E(acc, cur, wr, wc, fr, fq); S.done(cur); }
        if (!has_next) break;
#pragma unroll
        for (int a = 0; a < 2; ++a)
#pragma unroll
            for (int b = 0; b < 2; ++b)
#pragma unroll
                for (int m = 0; m < 4; ++m)
#pragma unroll
                    for (int n = 0; n < 2; ++n) acc[a][b][m][n] = (f32x4){0.f, 0.f, 0.f, 0.f};
        cur = nxt; cA = nA; cB = nB; ++ui;
        if constexpr (ALIGN_EPI) { if (wr == 1) PG8_BAR; }
    }
    PG8_WAIT_V(0);
    if constexpr (!ALIGN_EPI) { if (wr == 0) PG8_BAR; }
    PG8_BAR;
    if constexpr (Epi::AFTER_DRAIN) { E.fused(acc, cur, wr, wc, fr, fq, lds, wid, lane); S.done(cur); }
#undef PG8_SA
#undef PG8_SB
#undef PG8_STAGE
#undef PG8_LDA
#undef PG8_LDB
#undef PG8_MMA
#undef PG8_WAIT_V
#undef PG8_WAIT_L
#undef PG8_BAR
#undef PG8_SCHED
}
}
#include <hip/hip_bf16.h>
#include <cmath>
namespace attn_body {
using bf16=__hip_bfloat16;
using bf16x8=__attribute__((ext_vector_type(8)))short;
using s16x4=__attribute__((ext_vector_type(4)))short;
using f32x16=__attribute__((ext_vector_type(16)))float;
using u32x4=__attribute__((ext_vector_type(4)))unsigned;
constexpr int BATCH=8,NHEAD=16,SEQ=4096,D=64,DM=NHEAD*D;
constexpr int NW=8,QBLK=32,QB=QBLK*NW,KVBLK=64,NQB=SEQ/QB;
constexpr int ATTN_PITCH=DM, ATTN_UNIT_ROWS=QB;
__device__ __forceinline__ int crow(int r,int hi){return (r&3)+8*(r>>2)+4*hi;}
#define SBAR() __builtin_amdgcn_sched_barrier(0)
__device__ __forceinline__ void cmask(f32x16&p0,f32x16&p1,int jb,int qrel,int hi){
  const float NEG=-INFINITY; int kb=64*jb+4*hi; asm volatile("":"+v"(kb)); asm volatile("":"+v"(qrel));
  #pragma unroll
  for(int r=0;r<16;++r){int kv=kb+(r&3)+8*(r>>2); if(kv>qrel)p0[r]=NEG; if(kv+32>qrel)p1[r]=NEG;}
}

constexpr int NSLOT=3, SLOTB=8192; constexpr long KX_DELTA=7l<<20;
constexpr int LDS_K=0, LDS_V=NSLOT*SLOTB, LDS_WS=2*NSLOT*SLOTB, LDS_OST=LDS_WS+NW*64*4, LDS_C=LDS_OST+NW*4096, LDS_R=LDS_C+4352*4, LDS_Q=LDS_R+512, LDS_BYTES=LDS_Q+NW*4096;
constexpr float C2=0.125f*1.4426950408889634f;
__device__ __forceinline__ void glds16(const void*gsrc,unsigned lds_dst){unsigned keep;
  asm volatile("s_mov_b32 %0, m0\n\ts_mov_b32 m0, %2\n\ts_nop 0\n\tglobal_load_lds_dwordx4 %1, off\n\ts_mov_b32 m0, %0":"=&s"(keep):"v"(gsrc),"s"(lds_dst):"memory");}
__device__ __forceinline__ float max3f(float a,float b,float c){float r;asm("v_max3_f32 %0, %1, %2, %3":"=v"(r):"v"(a),"v"(b),"v"(c));return r;}
__device__ __forceinline__ float max2f(float a,float b){float r;asm("v_max_f32_e32 %0, %1, %2":"=v"(r):"v"(a),"v"(b));return r;}
__device__ __forceinline__ float fadd_s(float a,float b){float r;asm("v_add_f32_e32 %0, %1, %2":"=v"(r):"v"(a),"v"(b));return r;}
__device__ __forceinline__ float fsub_s(float a,float b){float r;asm("v_sub_f32_e32 %0, %1, %2":"=v"(r):"v"(a),"v"(b));return r;}
typedef float f32x2_t __attribute__((ext_vector_type(2))); typedef __bf16 bf16x2_t __attribute__((ext_vector_type(2)));
__device__ __forceinline__ unsigned cvtpk_s(float lo,float hi){f32x2_t v={lo,hi};bf16x2_t b=__builtin_convertvector(v,bf16x2_t);return __builtin_bit_cast(unsigned,b);}
#define WAIT_BAR(N) asm volatile("s_waitcnt vmcnt(" #N ") lgkmcnt(0)\n\ts_barrier":::"memory")

typedef __attribute__((address_space(3))) const char* lds_cptr0;
__device__ __forceinline__ void qkt(f32x16&p0,f32x16&p1,const char*Kslot,const bf16x8*qr,int r32,int hi){
  const char*kb=Kslot+hi*1024+r32*16;
  #pragma unroll
  for(int d0=0;d0<4;++d0){
    const bf16x8 b0=*reinterpret_cast<const bf16x8*>(kb+d0*2048);
    const bf16x8 b1=*reinterpret_cast<const bf16x8*>(kb+d0*2048+512);
    const bf16x8 qd=qr[d0];
    p0=__builtin_amdgcn_mfma_f32_32x32x16_bf16(b0,qd,p0,0,0,0);p1=__builtin_amdgcn_mfma_f32_32x32x16_bf16(b1,qd,p1,0,0,0);}
}
typedef __attribute__((address_space(3))) const char* lds_cptr;
typedef short v4i16_t __attribute__((ext_vector_type(4)));
__device__ __forceinline__ void kload8(bf16x8*kf,lds_cptr kp){
  kf[0]=*(const __attribute__((address_space(3))) bf16x8*)(kp);      kf[1]=*(const __attribute__((address_space(3))) bf16x8*)(kp+512);
  kf[2]=*(const __attribute__((address_space(3))) bf16x8*)(kp+2048); kf[3]=*(const __attribute__((address_space(3))) bf16x8*)(kp+2560);
  kf[4]=*(const __attribute__((address_space(3))) bf16x8*)(kp+4096); kf[5]=*(const __attribute__((address_space(3))) bf16x8*)(kp+4608);
  kf[6]=*(const __attribute__((address_space(3))) bf16x8*)(kp+6144); kf[7]=*(const __attribute__((address_space(3))) bf16x8*)(kp+6656);
}
__device__ __forceinline__ void kload2(bf16x8*kf,lds_cptr kp,int j){ kf[2*j]=*(const __attribute__((address_space(3))) bf16x8*)(kp+j*2048); kf[2*j+1]=*(const __attribute__((address_space(3))) bf16x8*)(kp+j*2048+512); }
__device__ __forceinline__ s16x4 vtr(lds_cptr p){ return __builtin_bit_cast(s16x4,__builtin_amdgcn_ds_read_tr16_b64_v4i16((__attribute__((address_space(3))) v4i16_t*)p)); }
__device__ __forceinline__ float rowmax(const f32x16&p0,const f32x16&p1){
  float a=max3f(p0[0],p0[1],p1[0]),b=max3f(p0[2],p0[3],p1[1]);a=max3f(a,p1[2],p1[3]);
  #pragma unroll
  for(int r=4;r<16;r+=4){a=max3f(a,p0[r],p0[r+1]);b=max3f(b,p0[r+2],p0[r+3]);a=max3f(a,p1[r],p1[r+1]);b=max3f(b,p1[r+2],p1[r+3]);}
  const float m=max2f(a,b);
  auto rr=__builtin_amdgcn_permlane32_swap(__float_as_uint(m),__float_as_uint(m),false,false);
  return max2f(__uint_as_float(rr[0]),__uint_as_float(rr[1]));
}
__device__ __forceinline__ void pv(f32x16*o,int vb,bf16x8 pa0,bf16x8 pa1,bf16x8 pa2,bf16x8 pa3){
  #pragma unroll
  for(int d0=0;d0<2;++d0){s16x4 lo[4],hi[4];
    #pragma unroll
    for(int ks=0;ks<4;++ks){
      asm volatile("ds_read_b64_tr_b16 %0,%1 offset:%c2":"=&v"(lo[ks]):"v"(vb),"i"(d0*4096+ks*1024):"memory");
      asm volatile("ds_read_b64_tr_b16 %0,%1 offset:%c2":"=&v"(hi[ks]):"v"(vb),"i"(d0*4096+ks*1024+512):"memory");}
    asm volatile("s_waitcnt lgkmcnt(0)":::"memory");SBAR();
    #define PK(k) (bf16x8){lo[k][0],lo[k][1],lo[k][2],lo[k][3],hi[k][0],hi[k][1],hi[k][2],hi[k][3]}
    o[d0]=__builtin_amdgcn_mfma_f32_32x32x16_bf16(pa0,PK(0),o[d0],0,0,0);
    o[d0]=__builtin_amdgcn_mfma_f32_32x32x16_bf16(pa1,PK(1),o[d0],0,0,0);
    o[d0]=__builtin_amdgcn_mfma_f32_32x32x16_bf16(pa2,PK(2),o[d0],0,0,0);
    o[d0]=__builtin_amdgcn_mfma_f32_32x32x16_bf16(pa3,PK(3),o[d0],0,0,0);
    #undef PK
  }
}

#ifndef ATTN_STORE16
#define ATTN_STORE16(p,v) (*(u32x4*)(p)=(v))
#endif
template<int THRL> __device__ __forceinline__ void attn_unit(const bf16*Qu,const bf16*__restrict__ Kh,const bf16*__restrict__ Vh,const long dO,const long dG,const float*__restrict__ cneg,const int NT,const unsigned stmask,char*shm,const int wv){
  int lane_=lane_id_(); asm volatile("":"+v"(lane_)); const int lane=lane_,tid=wv*64+lane,r32=lane&31,hi=lane>>5; const int wid=wv; const bool act=((stmask>>wv)&1u)!=0u;
  const bf16*Qw=Qu+(long)(wid*QBLK)*DM;
  const unsigned lds0=(unsigned)(uintptr_t)shm;
  float*wsf=(float*)(shm+LDS_WS)+wid*64;
  const bf16*ksrc=Kh+(long)lane*DM+wid*8;
  const bf16*vsrc=Vh+(long)(16*(wid&3)+(lane>>2))*DM+(wid>>2)*32+(lane&3)*8;
  const unsigned kdst=lds0+LDS_K+wid*1024, vdst=lds0+LDS_V+wid*1024;
  #define DMA_K(t,slot) glds16(ksrc+(long)(t)*KVBLK*DM,(unsigned)__builtin_amdgcn_readfirstlane(kdst+(slot)))
  #define DMA_V(t,slot) glds16(vsrc+(long)(t)*KVBLK*DM,(unsigned)__builtin_amdgcn_readfirstlane(vdst+(slot)))
  const int vb0=(int)(lds0+LDS_V)+((lane>>4)&1)*32+(lane&3)*8+(4*hi+((lane&15)>>2))*64;
  const char*Kbase=shm+LDS_K; bf16x8 kf[8];
  const lds_cptr shm3=(lds_cptr)shm; const lds_cptr kp0=shm3+LDS_K+hi*1024+r32*16; const lds_cptr vp0=shm3+LDS_V+((lane>>4)&1)*32+(lane&3)*8+(4*hi+((lane&15)>>2))*64;
  typedef __attribute__((address_space(3))) float* lds_fptr; typedef float f32x4c __attribute__((ext_vector_type(4)));
  typedef __attribute__((address_space(3))) unsigned* lds_uptr;
  const lds_uptr kx3=(lds_uptr)(shm3+LDS_C);
  const lds_fptr rl3=(lds_fptr)(shm3+LDS_R);
  { int t0_=tid; asm volatile("":"+v"(t0_)); unsigned cv_[9]; const unsigned* kxg=(const unsigned*)((const char*)cneg+KX_DELTA);
    #pragma unroll
    for(int u_=0;u_<9;++u_){ const int i_=t0_+u_*NW*64; cv_[u_]=(i_<NT*64)?kxg[i_]:0u; }
    const float rt0_=(t0_<NT)?cneg[64*t0_]:0.f;
    #pragma unroll
    for(int u_=0;u_<9;++u_){ const int i_=t0_+u_*NW*64; if(i_<NT*64)kx3[i_]=cv_[u_]; }
    if(t0_<NT)rl3[t0_]=rt0_; }
  typedef short s16x4b __attribute__((ext_vector_type(4)));
  const unsigned hm_=hi?0u:0xffffffffu;
  s16x4b bxa0_,bxa1_,bxq_;
  typedef unsigned u32x2b __attribute__((ext_vector_type(2)));
  #define BIASPREP(t) do{ const float nd_=rl3[t]-mhat; const unsigned nh_=cvtpk_s(nd_,0.f)&0xffffu; const float ndh_=__uint_as_float(nh_<<16); const unsigned nl_=cvtpk_s(nd_-ndh_,0.f)&0xffffu; \
    const unsigned k0_=kx3[(t)*64+r32]&hm_, k1_=kx3[(t)*64+32+r32]&hm_, on_=0x3f803f80u&hm_; \
    bxa0_=__builtin_bit_cast(s16x4b,(u32x2b){k0_,on_}); bxa1_=__builtin_bit_cast(s16x4b,(u32x2b){k1_,on_}); bxq_=__builtin_bit_cast(s16x4b,(u32x2b){on_,(nh_|(nl_<<16))&hm_}); }while(0)
  #define BIASMF(C0,C1) do{ C0=__builtin_amdgcn_mfma_f32_32x32x8bf16_1k(bxa0_,bxq_,zero16,0,0,0); C1=__builtin_amdgcn_mfma_f32_32x32x8bf16_1k(bxa1_,bxq_,zero16,0,0,0); }while(0)
  if(!act){
    int sc_=0,sn_=SLOTB;
    #define ROTI() do{sc_=sn_;sn_=(sn_==(NSLOT-1)*SLOTB)?0:sn_+SLOTB;}while(0)
    #define ENDWI(tt) do{ if((tt)+3<NT){WAIT_BAR(2);} else if((tt)+2<NT){WAIT_BAR(1);} else {WAIT_BAR(0);} }while(0)
    DMA_K(0,0);DMA_V(0,0);DMA_K(1,SLOTB);DMA_K(2,2*SLOTB);
    WAIT_BAR(3); WAIT_BAR(0);
    DMA_K(3,0);DMA_V(1,SLOTB); ROTI(); WAIT_BAR(2);
    int t=1;
    for(;t+5<NT;t+=2){ DMA_K(t+3,sc_);DMA_V(t+1,sn_); WAIT_BAR(2); ROTI(); DMA_K(t+4,sc_);DMA_V(t+2,sn_); WAIT_BAR(2); ROTI(); }
    for(;t+1<NT;t+=2){ if(t+3<NT){DMA_K(t+3,sc_);} if(t+1<NT){DMA_V(t+1,sn_);} ENDWI(t); ROTI(); if(t+4<NT){DMA_K(t+4,sc_);} if(t+2<NT){DMA_V(t+2,sn_);} ENDWI(t+1); ROTI(); }
    asm volatile("s_waitcnt lgkmcnt(0)\n\ts_barrier":::"memory");
    #undef ROTI
    #undef ENDWI
    return;
  }
  DMA_K(0,0);DMA_V(0,0);DMA_K(1,SLOTB);
  bf16x8 qr_[4];
  #pragma unroll
  for(int d0=0;d0<4;++d0)qr_[d0]=*reinterpret_cast<const bf16x8*>(&Qw[(long)r32*DM+d0*16+hi*8]);
  #define QL(d) qr_[d]
  float mhat=cneg[(NT-4)*64+wid*QBLK+r32],l_reg=0.f;     f32x16 o[2];o[0]=f32x16{};o[1]=f32x16{};const f32x16 zero16=f32x16{};
  const int qrel=wid*QBLK+r32;
  #define CMASK(P0,P1,t) do{int jb_=(t)-(NT-4); if(jb_>=0)cmask(P0,P1,jb_,qrel,hi);}while(0)
  bool resc=false;
  #define START(P0,P1) do{ const float rm=rowmax(P0,P1); resc=false; \
    { const float dl=__builtin_fmaxf(rm,0.f); mhat=fadd_s(mhat,dl); \
      _Pragma("unroll") for(int r=0;r<16;++r){P0[r]=fsub_s(P0[r],dl);P1[r]=fsub_s(P1[r],dl);} \
 } \
    _Pragma("unroll") for(int r=0;r<16;++r)P0[r]=__builtin_amdgcn_exp2f(P0[r]); }while(0)
  #define RESC() do{ if(resc){ asm volatile("s_waitcnt lgkmcnt(0)":::"memory"); \
      _Pragma("unroll") for(int d_=0;d_<2;++d_) _Pragma("unroll") for(int r=0;r<16;++r)o[d_][r]*=wsf[crow(r,hi)]; } }while(0)
  f32x16 pA0,pA1,pB0,pB1;
  int sl_prev=0,sl_cur=0,sl_next=SLOTB;
  #define ROT() do{sl_prev=sl_cur;sl_cur=sl_next;sl_next=(sl_next==(NSLOT-1)*SLOTB)?0:sl_next+SLOTB;}while(0)
  DMA_K(2,2*SLOTB);
  WAIT_BAR(3);
  BIASPREP(0);BIASMF(pA0,pA1);qkt(pA0,pA1,Kbase,qr_,r32,hi);asm volatile("s_nop 15\n\ts_nop 7":"+v"(pA0),"+v"(pA1));CMASK(pA0,pA1,0);
  START(pA0,pA1);
  BIASPREP(1);
  _Pragma("unroll") for(int r=0;r<16;++r)pA1[r]=__builtin_amdgcn_exp2f(pA1[r]);
  WAIT_BAR(0);
  DMA_K(3,0);DMA_V(1,SLOTB);
  ROT();
  kload8(kf,kp0+sl_cur);
  WAIT_BAR(2);
  s16x4 vlo[8],vhi[8]; u32x4 pw0,pw1,pw2,pw3;
  #define PKW(P,B) cvtpk_s(P[B],P[B+1])
  #define PAF(k) __builtin_bit_cast(bf16x8,pw##k)
  #define VFR(i) (bf16x8){vlo[i][0],vlo[i][1],vlo[i][2],vlo[i][3],vhi[i][0],vhi[i][1],vhi[i][2],vhi[i][3]}
  #define PIN(x) asm volatile("":"+v"(x))
  #define MX3(a,b,c) __builtin_fmaxf(__builtin_fmaxf((a),(b)),(c))
  #define GAPA(MF,A0,A1,A2,A3,W0,W1,PW) do{ MF; sacc+=A0; sacc+=A1; sacc+=A2; sacc+=A3; PIN(sacc); W0; W1; PIN(PW); SBAR(); }while(0)
  #define EX(v) __builtin_amdgcn_exp2f(v)
  #define GAPB(MF,X,B) do{ MF; X[B]=EX(X[B]); X[B+1]=EX(X[B+1]); X[B+2]=EX(X[B+2]); X[B+3]=EX(X[B+3]); PIN(X); SBAR(); }while(0)
  #define VRD(i) do{ vlo[i]=vtr(vp_+(((i)>>2)*4096+((i)&3)*1024)); vhi[i]=vtr(vp_+(((i)>>2)*4096+((i)&3)*1024+512)); }while(0)
  #define KRD(G,j) do{ if(G){ kload2(kf,kp0+sl_next,j); SBAR(); } }while(0)
  #define STEP(C0,C1,P0,P1,t,GK,GV,GL) do{ SBAR(); \
    const lds_cptr vp_=vp0+sl_prev; \
    VRD(0); const bf16x8 q0_=QL(0); BIASMF(C0,C1); SBAR(); float sacc=(P0[0]+P0[1]); \
    GAPA(C0=__builtin_amdgcn_mfma_f32_32x32x16_bf16(kf[0],q0_,C0,0,0,0), P0[2],P0[3],P0[4],P0[5],     pw0[0]=PKW(P0,0), pw0[1]=PKW(P0,2), pw0); \
    VRD(4); const bf16x8 q1_=QL(1); SBAR(); GAPA(C1=__builtin_amdgcn_mfma_f32_32x32x16_bf16(kf[1],q0_,C1,0,0,0), P0[6],P0[7],P0[8],P0[9],     pw0[2]=PKW(P0,4), pw0[3]=PKW(P0,6), pw0); \
    VRD(1); SBAR(); GAPA(C0=__builtin_amdgcn_mfma_f32_32x32x16_bf16(kf[2],q1_,C0,0,0,0),   P0[10],P0[11],P0[12],P0[13], pw1[0]=PKW(P0,8), pw1[1]=PKW(P0,10), pw1); \
    VRD(5); const bf16x8 q2_=QL(2); SBAR(); GAPA(C1=__builtin_amdgcn_mfma_f32_32x32x16_bf16(kf[3],q1_,C1,0,0,0),   P0[14],P0[15],P1[0],P1[1],   pw1[2]=PKW(P0,12),pw1[3]=PKW(P0,14), pw1); \
    VRD(2); SBAR(); GAPA(C0=__builtin_amdgcn_mfma_f32_32x32x16_bf16(kf[4],q2_,C0,0,0,0),   P1[2],P1[3],P1[4],P1[5],     pw2[0]=PKW(P1,0), pw2[1]=PKW(P1,2), pw2); \
    VRD(6); const bf16x8 q3_=QL(3); SBAR(); GAPA(C1=__builtin_amdgcn_mfma_f32_32x32x16_bf16(kf[5],q2_,C1,0,0,0),   P1[6],P1[7],P1[8],P1[9],     pw2[2]=PKW(P1,4), pw2[3]=PKW(P1,6), pw2); \
    VRD(3); SBAR(); GAPA(C0=__builtin_amdgcn_mfma_f32_32x32x16_bf16(kf[6],q3_,C0,0,0,0),   P1[10],P1[11],P1[12],P1[13], pw3[0]=PKW(P1,8), pw3[1]=PKW(P1,10), pw3); \
    VRD(7); SBAR(); GAPA(C1=__builtin_amdgcn_mfma_f32_32x32x16_bf16(kf[7],q3_,C1,0,0,0),   P1[14],P1[15],0.f,0.f,       pw3[2]=PKW(P1,12),pw3[3]=PKW(P1,14), pw3); \
    l_reg+=sacc; \
    if(GK){DMA_K((t)+3,sl_cur);} if(GV){DMA_V((t)+1,sl_next);} \
    CMASK(C0,C1,t); \
    { float a=MX3(C0[0],C0[1],C1[0]),b=MX3(C0[2],C0[3],C1[1]); a=MX3(a,C1[2],C1[3]); \
      _Pragma("unroll") for(int r=4;r<16;r+=4){a=MX3(a,C0[r],C0[r+1]);b=MX3(b,C0[r+2],C0[r+3]);a=MX3(a,C1[r],C1[r+1]);b=MX3(b,C1[r+2],C1[r+3]);} \
      float rm=__builtin_fmaxf(a,b); { auto rr=__builtin_amdgcn_permlane32_swap(__float_as_uint(rm),__float_as_uint(rm),false,false); rm=__builtin_fmaxf(__uint_as_float(rr[0]),__uint_as_float(rr[1])); } \
      resc=false; \
      if(__builtin_expect(__any(rm>(float)THRL),0)){ const float dl=__builtin_fmaxf(rm,0.f); mhat+=dl; \
        _Pragma("unroll") for(int r=0;r<16;++r){C0[r]-=dl;C1[r]-=dl;} \
        const float f=__builtin_amdgcn_exp2f(-dl); l_reg*=f; if(hi==0)wsf[r32]=f; resc=true; } } \
    SBAR(); \
    GAPB(o[0]=__builtin_amdgcn_mfma_f32_32x32x16_bf16(PAF(0),VFR(0),o[0],0,0,0), C0,0); \
    GAPB(o[1]=__builtin_amdgcn_mfma_f32_32x32x16_bf16(PAF(0),VFR(4),o[1],0,0,0), C0,4); \
    KRD(GL,0); GAPB(o[0]=__builtin_amdgcn_mfma_f32_32x32x16_bf16(PAF(1),VFR(1),o[0],0,0,0), C0,8); \
    KRD(GL,1); GAPB(o[1]=__builtin_amdgcn_mfma_f32_32x32x16_bf16(PAF(1),VFR(5),o[1],0,0,0), C0,12); \
    KRD(GL,2); GAPB(o[0]=__builtin_amdgcn_mfma_f32_32x32x16_bf16(PAF(2),VFR(2),o[0],0,0,0), C1,0); \
    KRD(GL,3); GAPB(o[1]=__builtin_amdgcn_mfma_f32_32x32x16_bf16(PAF(2),VFR(6),o[1],0,0,0), C1,4); \
    GAPB(o[0]=__builtin_amdgcn_mfma_f32_32x32x16_bf16(PAF(3),VFR(3),o[0],0,0,0), C1,8); \
    GAPB(o[1]=__builtin_amdgcn_mfma_f32_32x32x16_bf16(PAF(3),VFR(7),o[1],0,0,0), C1,12); \
    BIASPREP((t)+1); \
    }while(0)
  int t=1;
  #undef CMASK
  #define CMASK(P0,P1,t) do{}while(0)
  for(;t+5<NT;t+=2){
    STEP(pB0,pB1,pA0,pA1,t,true,true,true);     WAIT_BAR(2); RESC(); ROT();
    STEP(pA0,pA1,pB0,pB1,t+1,true,true,true);   WAIT_BAR(2); RESC(); ROT();
  }
  #undef CMASK
  #define CMASK(P0,P1,t) do{int jb_=(t)-(NT-4); if(jb_>=0)cmask(P0,P1,jb_,qrel,hi);}while(0)
  #define ENDW(tt) do{ if((tt)+3<NT){WAIT_BAR(2);} else if((tt)+2<NT){WAIT_BAR(1);} else {WAIT_BAR(0);} }while(0)
  for(;t+1<NT;t+=2){
    STEP(pB0,pB1,pA0,pA1,t,(t+3<NT),(t+1<NT),(t+1<NT));       ENDW(t);   RESC(); ROT();
    STEP(pA0,pA1,pB0,pB1,t+1,(t+4<NT),(t+2<NT),(t+2<NT));     ENDW(t+1); RESC(); ROT();
  }
  STEP(pB0,pB1,pA0,pA1,NT-1,false,false,false); RESC();
  { float sacc=pB0[0]+pB0[1]; _Pragma("unroll") for(int r=2;r<16;++r)sacc+=pB0[r]; _Pragma("unroll") for(int r=0;r<16;++r)sacc+=pB1[r]; l_reg+=sacc;
    pw0=(u32x4){PKW(pB0,0),PKW(pB0,2),PKW(pB0,4),PKW(pB0,6)};pw1=(u32x4){PKW(pB0,8),PKW(pB0,10),PKW(pB0,12),PKW(pB0,14)};pw2=(u32x4){PKW(pB1,0),PKW(pB1,2),PKW(pB1,4),PKW(pB1,6)};pw3=(u32x4){PKW(pB1,8),PKW(pB1,10),PKW(pB1,12),PKW(pB1,14)};
    SBAR(); pv(o,vb0+sl_cur,PAF(0),PAF(1),PAF(2),PAF(3)); }
  #undef PKW
  #undef PAF
  #undef VFR
  #undef PIN
  #undef MX3
  #undef GAPA
  #undef GAPB
  #undef EX
  #undef VRD
  #undef KRD
  #undef STEP
  #undef ENDW
  {auto rr=__builtin_amdgcn_permlane32_swap(__float_as_uint(l_reg),__float_as_uint(l_reg),false,false);l_reg=__uint_as_float(rr[0])+__uint_as_float(rr[1]);}
  if(hi==0)wsf[32+r32]=l_reg;asm volatile("s_waitcnt lgkmcnt(0)":::"memory");
  float rli[16];
  #pragma unroll
  for(int r=0;r<16;++r)rli[r]=__builtin_amdgcn_rcpf(wsf[32+crow(r,hi)]);
  bf16*Ow=const_cast<bf16*>(Qu)+dO+(long)(wid*QBLK)*DM; const bf16*Gw=Qu+dG+(long)(wid*QBLK)*DM; const bool dost=((stmask>>wid)&1u)!=0u;
  { bf16*stg=(bf16*)(shm+LDS_OST)+wid*2048;
    #pragma unroll
    for(int r=0;r<16;++r){const int orow=crow(r,hi);
      #pragma unroll
      for(int d0=0;d0<2;++d0)stg[orow*64+d0*32+r32]=__float2bfloat16(o[d0][r]*rli[r]);}
    asm volatile("s_waitcnt lgkmcnt(0)":::"memory");
    int le_=lane; asm volatile("":"+v"(le_));
    #pragma unroll
    for(int i=0;i<4;++i){const int row=i*8+(le_>>3),ch=le_&7; const u32x4 v=*(const u32x4*)(stg+row*64+ch*8);
      if(dost){ const u32x4 g=*(const u32x4*)(Gw+(long)row*DM+ch*8); u32x4 w;
        #pragma unroll
        for(int j=0;j<4;++j){ const float vl=__uint_as_float(v[j]<<16),vh=__uint_as_float(v[j]&0xffff0000u),gl=__uint_as_float(g[j]<<16),gh=__uint_as_float(g[j]&0xffff0000u); w[j]=cvtpk_s(vl*gl,vh*gh); }
        ATTN_STORE16(Ow+(long)row*DM+ch*8,w);} } }
  asm volatile("s_waitcnt lgkmcnt(0)\n\ts_barrier":::"memory");
  #undef DMA_K
  #undef DMA_V
  #undef BIASMF
  #undef BIASPREP
  #undef QL
  #undef CMASK
  #undef START
  #undef RESC
  #undef ROT
}
constexpr int ATTN_LDS_BYTES=LDS_BYTES;
#undef SBAR
#undef WAIT_BAR
}
#define GAS __attribute__((address_space(1)))
#define LAS __attribute__((address_space(3)))
typedef unsigned short bf16;
typedef unsigned v4u __attribute__((ext_vector_type(4)));
typedef unsigned v2u __attribute__((ext_vector_type(2)));
typedef float f32x4 __attribute__((ext_vector_type(4)));
typedef short bf16x8 __attribute__((ext_vector_type(8)));
#define LDS_WAIT() asm volatile("s_waitcnt lgkmcnt(0)" ::: "memory")
constexpr int NWAVES = 8, NTHREADS = 512;
constexpr int LDS_BYTES = 147456;
constexpr size_t MiB = 1u << 20;
constexpr size_t WS_WGU00 = 1 * MiB, WS_WGU01 = 12 * MiB, WS_WKVF = 23 * MiB, WS_WGU10 = WS_WKVF + 4608 * 1024  , WS_WGU11 = WS_WGU10 + 11 * MiB;
constexpr size_t WS_WDN = WS_WGU11 + 11 * MiB  , WDN_BYTES = (size_t)1024 * 2816 * 2  ;
constexpr size_t WS_WIN = WS_WDN + 4 * WDN_BYTES  , WS_WOA = WS_WIN + (size_t)K::NIN * 1024 * 2  , WS_WQG = WS_WOA + 2 * MiB, WS_WOB = WS_WQG + 4 * MiB  ;
constexpr size_t WS_HB = 86 * MiB, WS_PSQ = 152 * MiB, WS_GL = 155 * MiB, WS_OSQ = 158 * MiB, WS_CP = 167 * MiB, WS_CS = 169 * MiB;
constexpr size_t WS_ACT = 182 * MiB, WS_O = WS_ACT  ;
constexpr size_t WS_KS = 364 * MiB, WS_VS = 500 * MiB;
constexpr size_t WS_GQ = 636 * MiB, WS_GK = 669 * MiB, WS_GV = 702 * MiB, WS_GR = 768 * MiB, WS_OB = 834 * MiB;
constexpr size_t WS_QP = 636 * MiB  , WS_KP = 703 * MiB, WS_VP = 767 * MiB, WS_GATE = 831 * MiB, WS_AO = 900 * MiB, WS_END = 966 * MiB;
static_assert(WS_WGU10 - WS_WKVF == (size_t)K::NKVF * 1024 * 2, "kvf | gu10 contiguous");
static_assert(WS_WOB + 2 * MiB <= WS_HB && WS_HB + (size_t)K::M * 2048 <= WS_PSQ && WS_PSQ + (size_t)K::M * 64 <= WS_GL && WS_GL + (size_t)K::M * 64 <= WS_OSQ && WS_OSQ + (size_t)K::M * 256 <= WS_CP, "map1");
static_assert(WS_CP + 2 * MiB <= WS_CS && WS_CS + (size_t)256 * K::SKR * 4 <= WS_CP + 7 * MiB && WS_CS + 7 * MiB + (size_t)256 * K::SKR * 4 <= WS_ACT && WS_ACT + (size_t)K::M * K::FF * 2 <= WS_KS && WS_O + (size_t)K::M * 4096 <= WS_KS, "map2");
static_assert(WS_KS + (size_t)16 * K::SKR * 2048 <= WS_VS && WS_VS + (size_t)16 * K::SKR * 2048 <= WS_GQ, "map3");
static_assert(WS_GQ + (size_t)K::M * 1024 <= WS_GK && WS_GK + (size_t)K::M * 1024 <= WS_GV && WS_GV + (size_t)K::M * 2048 <= WS_GR && WS_GR + (size_t)K::M * 2048 <= WS_OB && WS_OB + (size_t)K::M * 2048 <= WS_AO, "map4");
static_assert(WS_QP + (size_t)(K::M + 192) * 2048 <= WS_KP && WS_KP + 64 * MiB <= WS_VP && WS_VP + 64 * MiB <= WS_GATE && WS_GATE + (size_t)K::M * 2048 <= WS_AO && WS_AO + (size_t)K::M * 2048 <= WS_END, "map5");

struct Args {
    const float *x_p, *x_s, *state, *cache_k, *cache_v, *cache_lf, *ffn_norm, *w_gu, *w_dn, *mix_norm, *a_w_in, *a_w_g2, *a_b_g, *a_g_out, *a_w_o, *kv_norm, *w_kvf, *b_f, *g_k, *b_w_qg, *b_g_q, *b_w_o;
    float* out; unsigned char* ws;
};

__device__ __forceinline__ float wave_sum(float v) {
#pragma unroll
    for (int o = 1; o < 64; o <<= 1) v += __shfl_xor(v, o);
    return v;
}
__device__ __forceinline__ float bf2f(unsigned short u) { return __uint_as_float((unsigned)u << 16); }
__device__ __forceinline__ unsigned short f2bf(float f) { return (unsigned short)(pg8::pkbf(f, 0.f) & 0xffffu); }

__device__ __forceinline__ void tr_item(const float* W, int ldw, int nvalid, const float* gain, bf16* WT, int Kd, int k0, int nsrc0, int ndst0, LAS float* scr, int lane) {
    const int n = nsrc0 + (lane & 31); const bool ok = n < nvalid;
    float wv_[32];
#pragma unroll
    for (int i = 0; i < 32; ++i) { const int kk = 2 * i + (lane >> 5); wv_[i] = ok ? W[(size_t)(k0 + kk) * ldw + n] : 0.f; }
#pragma unroll
    for (int i = 0; i < 32; ++i) { const int kk = 2 * i + (lane >> 5); float v = wv_[i]; if (gain) v *= gain[k0 + kk]; scr[kk * 33 + (lane & 31)] = v; }
    LDS_WAIT(); asm volatile("" ::: "memory");
    const int c = lane & 7;
#pragma unroll
    for (int j = 0; j < 4; ++j) { const int nn = (lane >> 3) + 8 * j; const LAS float* s = scr + (8 * c) * 33 + nn;
        v4u o; o.x = pg8::pkbf(s[0 * 33], s[1 * 33]); o.y = pg8::pkbf(s[2 * 33], s[3 * 33]); o.z = pg8::pkbf(s[4 * 33], s[5 * 33]); o.w = pg8::pkbf(s[6 * 33], s[7 * 33]);
        *(v4u*)(WT + (size_t)(ndst0 + nn) * Kd + k0 + 8 * c) = o; }
    LDS_WAIT(); asm volatile("" ::: "memory");
}
__device__ __forceinline__ int headperm32(int n) { const int pn = n >> 8, nl = n & 255; return pn * 256 + ((nl & 63) >> 5) * 128 + (nl >> 6) * 32; }
__device__ __forceinline__ int guperm32(int n) { if (n < K::FF) return (n >> 7) * 256 + (n & 127); const int j = n - K::FF; return (j >> 7) * 256 + 128 + (j & 127); }

__device__ __forceinline__ void p0_prologue(const Args& A, LAS unsigned char* lds, int gw, int NGW, int lane, int wave) {
    unsigned char* ws = A.ws;
    LAS float* scr = (LAS float*)(lds + wave * 16384);
    constexpr int I_GU = 16 * (K::NGU / 32), I_DN = (K::FF / 64) * 32, I_IN = 16 * (K::NIN / 32), I_OA = 16 * 32, I_KVF = 16 * (K::NKVF / 32), I_QG = 16 * (K::NQG / 32), I_OB = 16 * 32;
    constexpr int NITEMS = 4 * I_GU + 4 * I_DN + I_IN + I_OA + I_KVF + I_QG + I_OB;
    for (int it = gw; it < NITEMS; it += NGW) {
        int r = it;
        if (r < 4 * I_GU) { const int mi = r / I_GU; r -= mi * I_GU; const int nb = r % (K::NGU / 32), kb = r / (K::NGU / 32);
            const size_t wsoff = mi == 0 ? WS_WGU00 : mi == 1 ? WS_WGU01 : mi == 2 ? WS_WGU10 : WS_WGU11;
            tr_item(A.w_gu + (size_t)mi * 1024 * K::NGU, K::NGU, K::NGU, A.ffn_norm + mi * 1024, (bf16*)(ws + wsoff), 1024, kb * 64, nb * 32, guperm32(nb * 32), scr, lane); continue; }
        r -= 4 * I_GU;
        if (r < 4 * I_DN) { const int mi = r / I_DN; r -= mi * I_DN; const int nb = r % 32, kb = r / 32;
            tr_item(A.w_dn + (size_t)mi * K::FF * 1024, 1024, 1024, nullptr, (bf16*)(ws + WS_WDN + mi * WDN_BYTES), K::FF, kb * 64, nb * 32, nb * 32, scr, lane); continue; }
        r -= 4 * I_DN;
        if (r < I_IN) { const int nb = r % (K::NIN / 32), kb = r / (K::NIN / 32);
            tr_item(A.a_w_in, K::NIN_SRC, K::NIN_SRC, A.mix_norm, (bf16*)(ws + WS_WIN), 1024, kb * 64, nb * 32, nb * 32, scr, lane); continue; }
        r -= I_IN;
        if (r < I_OA) { const int nb = r % 32, kb = r / 32; tr_item(A.a_w_o, 1024, 1024, nullptr, (bf16*)(ws + WS_WOA), 1024, kb * 64, nb * 32, nb * 32, scr, lane); continue; }
        r -= I_OA;
        if (r < I_KVF) { const int nb = r % (K::NKVF / 32), kb = r / (K::NKVF / 32);
            tr_item(A.w_kvf, K::NKVF_SRC, K::NKVF_SRC, A.kv_norm, (bf16*)(ws + WS_WKVF), 1024, kb * 64, nb * 32, headperm32(nb * 32), scr, lane); continue; }
        r -= I_KVF;
        if (r < I_QG) { const int nb = r % (K::NQG / 32), kb = r / (K::NQG / 32);
            tr_item(A.b_w_qg, K::NQG, K::NQG, A.mix_norm + 1024, (bf16*)(ws + WS_WQG), 1024, kb * 64, nb * 32, headperm32(nb * 32), scr, lane); continue; }
        r -= I_QG;
        { const int nb = r % 32, kb = r / 32; tr_item(A.b_w_o, 1024, 1024, nullptr, (bf16*)(ws + WS_WOB), 1024, kb * 64, nb * 32, nb * 32, scr, lane); }
    }
    bf16* HB = (bf16*)(ws + WS_HB); float* PSQ = (float*)(ws + WS_PSQ);
    for (int m0 = gw; m0 < K::M; m0 += 2 * NGW) {
        f32x4 v[2][4]; float s[2];
#pragma unroll
        for (int rr = 0; rr < 2; ++rr) { const int m = m0 + rr * NGW; if (m < K::M) { const float* xr = (m < K::MP) ? A.x_p + (size_t)m * 1024 : A.x_s + (size_t)(m - K::MP) * 1024; const f32x4* x4 = (const f32x4*)xr + lane;
#pragma unroll
                for (int j = 0; j < 4; ++j) v[rr][j] = x4[64 * j]; } }
#pragma unroll
        for (int rr = 0; rr < 2; ++rr) { const int m = m0 + rr * NGW; if (m < K::M) { s[rr] = 0.f;
#pragma unroll
                for (int j = 0; j < 4; ++j) s[rr] += (v[rr][j][0] * v[rr][j][0] + v[rr][j][1] * v[rr][j][1]) + (v[rr][j][2] * v[rr][j][2] + v[rr][j][3] * v[rr][j][3]);
                s[rr] = wave_sum(s[rr]);
                v2u* o8 = (v2u*)(HB + (size_t)m * 1024) + lane;
#pragma unroll
                for (int j = 0; j < 4; ++j) { v2u w; w.x = pg8::pkbf(v[rr][j][0], v[rr][j][1]); w.y = pg8::pkbf(v[rr][j][2], v[rr][j][3]); o8[64 * j] = w; }
                if (lane < 16) PSQ[(size_t)m * 16 + lane] = (lane == 0) ? s[rr] : 0.f;
 } }
    }
    {
        const size_t tid_g = (size_t)gw * 64 + lane, nth = (size_t)NGW * 64;
        const size_t nvec = (size_t)16 * K::PAST * 1024 / 8;
        for (int which = 0; which < 2; ++which) {
            const float* src = which ? A.cache_v : A.cache_k; bf16* dst = (bf16*)(ws + (which ? WS_VS : WS_KS));
            const size_t nz = (size_t)16 * 192 * 1024 / 8;
            for (size_t i = tid_g; i < nz; i += nth) { const size_t e = i * 8, b = e / (192 * 1024), rem = e - b * 192 * 1024; *(v4u*)(dst + (b * K::SKR + K::PAST + 64) * 1024 + rem) = (v4u){0u, 0u, 0u, 0u}; }
        }
    }
}

constexpr size_t WS_QE = 900 * MiB, WS_KDT = 933 * MiB, WS_ATT = 314 * MiB, WS_DEC = 331 * MiB, WS_VT = WS_VS  ;
static_assert(WS_O + (size_t)K::M * 4096 <= WS_ATT && WS_ATT + (size_t)2112 * 8192 <= WS_DEC && WS_DEC + (size_t)2112 * 512 <= WS_KS && WS_QE + (size_t)2112 * 16384 <= WS_KDT && WS_KDT + (size_t)2112 * 16384 <= WS_END, "gla map");
__device__ __forceinline__ void gla_prep_item(const Args& A, LAS unsigned char* lds, int it, int tid) {
    const int lane = tid & 63, w = __builtin_amdgcn_readfirstlane(tid >> 6), fr = lane & 15, fq = lane >> 4;
    unsigned char* ws = A.ws;
    LAS bf16* Qe = (LAS bf16*)(lds);
    LAS bf16* Ke = (LAS bf16*)(lds + 17408);
    LAS float* glS = (LAS float*)(lds + 34816);
    LAS float* part = (LAS float*)(lds + 38912);
    const bf16* GQ = (const bf16*)(ws + WS_GQ); const bf16* GK = (const bf16*)(ws + WS_GK); const bf16* GV = (const bf16*)(ws + WS_GV); const float* GL = (const float*)(ws + WS_GL);
    bf16* QE = (bf16*)(ws + WS_QE); bf16* KDT = (bf16*)(ws + WS_KDT); bf16* ATT = (bf16*)(ws + WS_ATT); float* DEC = (float*)(ws + WS_DEC); bf16* VT = (bf16*)(ws + WS_VT);
    const int h = it & 3, m0 = (it >> 2) * 64;
    const int d = tid & 127, tg = tid >> 7;
    float w2[16];
#pragma unroll
    for (int j = 0; j < 16; ++j) w2[j] = A.a_w_g2[j * 512 + h * 128 + d];
    const float bg = A.a_b_g[h * 128 + d];
    if (tid < 256) *(LAS f32x4*)(glS + tid * 4) = *(const f32x4*)(GL + (size_t)m0 * 16 + tid * 4);
    unsigned short qv[16], kv[16];
#pragma unroll
    for (int i = 0; i < 16; ++i) { const size_t o = (size_t)(m0 + tg * 16 + i) * 512 + h * 128 + d; qv[i] = GQ[o]; kv[i] = GK[o]; }
    const int ve_ = tid & 255, vh_ = tid >> 8; unsigned vpk[16];
#pragma unroll
    for (int i = 0; i < 16; ++i) { const unsigned a = GV[(size_t)(m0 + vh_ * 32 + 2 * i) * 1024 + h * 256 + ve_], b2 = GV[(size_t)(m0 + vh_ * 32 + 2 * i + 1) * 1024 + h * 256 + ve_]; vpk[i] = a | (b2 << 16); }
    __syncthreads();
    float bl[16]; float run = 0.f;
#pragma unroll
    for (int i = 0; i < 16; ++i) { const LAS f32x4* g4 = (const LAS f32x4*)(glS + (tg * 16 + i) * 16); float z = bg;
#pragma unroll
        for (int j4 = 0; j4 < 4; ++j4) { const f32x4 g = g4[j4]; z += g[0] * w2[4 * j4] + g[1] * w2[4 * j4 + 1] + g[2] * w2[4 * j4 + 2] + g[3] * w2[4 * j4 + 3]; }
        run += pg8::logsigmoid_f(z) * (1.0f / 16.0f); bl[i] = run; }
    part[tg * 128 + d] = run;
    __syncthreads();
    float prefix = 0.f, tot = 0.f;
#pragma unroll
    for (int g = 0; g < 4; ++g) { const float pv = part[g * 128 + d]; tot += pv; if (g < tg) prefix += pv; }
    const float dect_ = __builtin_amdgcn_exp2f(tot * K::LOG2E);
    if (tg == 0) DEC[(size_t)it * 128 + d] = dect_;
    {
        float kd[16];
#pragma unroll
        for (int i = 0; i < 16; ++i) { const int l = tg * 16 + i; const float bb = (prefix + bl[i]) * K::LOG2E; const float q = bf2f(qv[i]), k = bf2f(kv[i]);
            const unsigned short qe = f2bf(q * __builtin_amdgcn_exp2f(bb));
            Qe[l * 136 + d] = qe; QE[((size_t)it * 64 + l) * 128 + d] = qe; const float ke_ = k * __builtin_amdgcn_exp2f(-bb); Ke[l * 136 + d] = f2bf(ke_); kd[i] = ke_ * dect_; }
        v4u p0, p1; p0.x = pg8::pkbf(kd[0], kd[1]); p0.y = pg8::pkbf(kd[2], kd[3]); p0.z = pg8::pkbf(kd[4], kd[5]); p0.w = pg8::pkbf(kd[6], kd[7]);
        p1.x = pg8::pkbf(kd[8], kd[9]); p1.y = pg8::pkbf(kd[10], kd[11]); p1.z = pg8::pkbf(kd[12], kd[13]); p1.w = pg8::pkbf(kd[14], kd[15]);
        v4u* kdst = (v4u*)(KDT + ((size_t)it * 128 + d) * 64 + tg * 16); kdst[0] = p0; kdst[1] = p1;
    }
    {
        v4u* vdst = (v4u*)(VT + ((size_t)it * 256 + ve_) * 64 + vh_ * 32);
#pragma unroll
        for (int i = 0; i < 4; ++i) vdst[i] = (v4u){vpk[4 * i], vpk[4 * i + 1], vpk[4 * i + 2], vpk[4 * i + 3]};
    }
    __syncthreads();
#pragma unroll
    for (int i = 0; i < 2; ++i) { const int ti = w * 2 + i, mt = ti >> 2, lt = ti & 3; f32x4 acc = {0.f, 0.f, 0.f, 0.f};
#pragma unroll
        for (int kk = 0; kk < 4; ++kk) { const bf16x8 a = *(const LAS bf16x8*)(Ke + (mt * 16 + fr) * 136 + kk * 32 + 8 * fq), bq = *(const LAS bf16x8*)(Qe + (lt * 16 + fr) * 136 + kk * 32 + 8 * fq);
            acc = __builtin_amdgcn_mfma_f32_16x16x32_bf16(a, bq, acc, 0, 0, 0); }
        const int l = lt * 16 + fr, mb = mt * 16 + 4 * fq;
#pragma unroll
        for (int r = 0; r < 4; ++r) if (mb + r > l) acc[r] = 0.f;
        v2u pk; pk.x = pg8::pkbf(acc[0], acc[1]); pk.y = pg8::pkbf(acc[2], acc[3]); *(v2u*)(ATT + ((size_t)it * 64 + l) * 64 + mb) = pk; }
    __syncthreads();
}

constexpr size_t WS_SS = WS_O;
struct ScanFrags { bf16x8 aK[2], bV[2][2]; f32x4 dc; };
__device__ __forceinline__ void scan_load(ScanFrags& F, const unsigned char* ws, int it, int es, int w, int fr, int fq) {
    const bf16* KDT = (const bf16*)(ws + WS_KDT); const float* DEC = (const float*)(ws + WS_DEC); const bf16* VT = (const bf16*)(ws + WS_VT);
#pragma unroll
    for (int kk = 0; kk < 2; ++kk) { F.aK[kk] = *(const bf16x8*)(KDT + ((size_t)it * 128 + w * 16 + fr) * 64 + kk * 32 + 8 * fq);
#pragma unroll
        for (int t = 0; t < 2; ++t) F.bV[t][kk] = *(const bf16x8*)(VT + ((size_t)it * 256 + es * 32 + t * 16 + fr) * 64 + kk * 32 + 8 * fq); }
    F.dc = *(const f32x4*)(DEC + (size_t)it * 128 + w * 16 + 4 * fq);
}
template <int NCH> __device__ __forceinline__ void gla_scan_item(const Args& A, int b, int h, int es, int tid) {
    const int lane = tid & 63, w = __builtin_amdgcn_readfirstlane(tid >> 6), fr = lane & 15, fq = lane >> 4;
    unsigned char* ws = A.ws; bf16* SS = (bf16*)(ws + WS_SS);
    constexpr bool samp = NCH == 1; constexpr int PF = NCH == 1 ? 1 : 7;
    const int ci0 = samp ? 512 + b : b * 64;
    f32x4 S[2];
#pragma unroll
    for (int t = 0; t < 2; ++t)
#pragma unroll
        for (int r = 0; r < 4; ++r) S[t][r] = samp ? A.state[((size_t)(b * 4 + h) * 128 + (w * 16 + 4 * fq + r)) * 256 + es * 32 + t * 16 + fr] : 0.f;
    ScanFrags F[PF];
    if (NCH == 1) scan_load(F[0], ws, ci0 * 4 + h, es, w, fr, fq);
    else {
#pragma unroll
        for (int c = 0; c < PF - 1; ++c) scan_load(F[c], ws, (ci0 + c) * 4 + h, es, w, fr, fq);
    }
#pragma unroll
    for (int c = 0; c < NCH; ++c) {
        if (NCH > 1 && c + PF - 1 < NCH) scan_load(F[(c + PF - 1) % PF], ws, (ci0 + c + PF - 1) * 4 + h, es, w, fr, fq);
        const int it = (ci0 + c) * 4 + h;
#pragma unroll
        for (int t = 0; t < 2; ++t) {
            v2u pk; pk.x = pg8::pkbf(S[t][0], S[t][1]); pk.y = pg8::pkbf(S[t][2], S[t][3]);
            *(v2u*)(SS + ((size_t)it * 256 + es * 32 + t * 16 + fr) * 128 + w * 16 + 4 * fq) = pk;
#pragma unroll
            for (int r = 0; r < 4; ++r) S[t][r] *= F[c % PF].dc[r];
#pragma unroll
            for (int kk = 0; kk < 2; ++kk) S[t] = __builtin_amdgcn_mfma_f32_16x16x32_bf16(F[c % PF].aK[kk], F[c % PF].bV[t][kk], S[t], 0, 0, 0); }
    }
    float* so = A.out + (samp ? K::O_GLAS : K::O_GLAP);
#pragma unroll
    for (int t = 0; t < 2; ++t)
#pragma unroll
        for (int r = 0; r < 4; ++r) so[((size_t)(b * 4 + h) * 128 + (w * 16 + 4 * fq + r)) * 256 + es * 32 + t * 16 + fr] = S[t][r];
}

struct OutB { bf16x8 bS[2][4], bV[2][2]; };
__device__ __forceinline__ void gla_out_loadB(OutB& B, const unsigned char* ws, int it, int w, int fr, int fq) {
    const bf16* VT = (const bf16*)(ws + WS_VT); const bf16* SS = (const bf16*)(ws + WS_SS);
#pragma unroll
    for (int t = 0; t < 2; ++t) {
#pragma unroll
        for (int kk = 0; kk < 4; ++kk) B.bS[t][kk] = *(const bf16x8*)(SS + ((size_t)it * 256 + w * 32 + t * 16 + fr) * 128 + kk * 32 + 8 * fq);
#pragma unroll
        for (int kk = 0; kk < 2; ++kk) B.bV[t][kk] = *(const bf16x8*)(VT + ((size_t)it * 256 + w * 32 + t * 16 + fr) * 64 + kk * 32 + 8 * fq); }
}
__device__ __forceinline__ void gla_out_item(const Args& A, LAS unsigned char* lds, int it, int tid, OutB& Bc, int it_next) {
    const int lane = tid & 63, w = __builtin_amdgcn_readfirstlane(tid >> 6), fr = lane & 15, fq = lane >> 4;
    unsigned char* ws = A.ws;
    const bf16* QE = (const bf16*)(ws + WS_QE); const bf16* ATT = (const bf16*)(ws + WS_ATT); const bf16* VT = (const bf16*)(ws + WS_VT); const bf16* SS = (const bf16*)(ws + WS_SS);
    const bf16* GR = (const bf16*)(ws + WS_GR); bf16* OB = (bf16*)(ws + WS_OB);
    LAS float* OT = (LAS float*)lds;
    const int h = it & 3, m0 = (it >> 2) * 64;
#pragma unroll
    for (int lt = 0; lt < 4; ++lt) {
        bf16x8 aQ[4], aA[2];
#pragma unroll
        for (int kk = 0; kk < 4; ++kk) aQ[kk] = *(const bf16x8*)(QE + ((size_t)it * 64 + lt * 16 + fr) * 128 + kk * 32 + 8 * fq);
#pragma unroll
        for (int kk = 0; kk < 2; ++kk) aA[kk] = *(const bf16x8*)(ATT + ((size_t)it * 64 + lt * 16 + fr) * 64 + kk * 32 + 8 * fq);
#pragma unroll
        for (int t = 0; t < 2; ++t) { f32x4 acc = {0.f, 0.f, 0.f, 0.f};
#pragma unroll
            for (int kk = 0; kk < 4; ++kk) acc = __builtin_amdgcn_mfma_f32_16x16x32_bf16(aQ[kk], Bc.bS[t][kk], acc, 0, 0, 0);
#pragma unroll
            for (int kk = 0; kk < 2; ++kk) acc = __builtin_amdgcn_mfma_f32_16x16x32_bf16(aA[kk], Bc.bV[t][kk], acc, 0, 0, 0);
#pragma unroll
            for (int r = 0; r < 4; ++r) OT[(lt * 16 + 4 * fq + r) * 260 + w * 32 + t * 16 + fr] = acc[r]; }
    }
    if (it_next < 2112) gla_out_loadB(Bc, ws, it_next, w, fr, fq);
    const int c8 = tid & 31;
    const f32x4 g0 = *(const f32x4*)(A.a_g_out + c8 * 8), g1 = *(const f32x4*)(A.a_g_out + c8 * 8 + 4);
    v4u rrv[4];
#pragma unroll
    for (int p = 0; p < 4; ++p) rrv[p] = *(const v4u*)(GR + (size_t)(m0 + p * 16 + (tid >> 5)) * 1024 + h * 256 + c8 * 8);
    __syncthreads();
#pragma unroll
    for (int p = 0; p < 4; ++p) { const int l = p * 16 + (tid >> 5);
        const f32x4 o0 = *(const LAS f32x4*)(OT + l * 260 + c8 * 8), o1 = *(const LAS f32x4*)(OT + l * 260 + c8 * 8 + 4);
        float s = (o0[0] * o0[0] + o0[1] * o0[1]) + (o0[2] * o0[2] + o0[3] * o0[3]) + (o1[0] * o1[0] + o1[1] * o1[1]) + (o1[2] * o1[2] + o1[3] * o1[3]);
        s += __shfl_xor(s, 1); s += __shfl_xor(s, 2); s += __shfl_xor(s, 4); s += __shfl_xor(s, 8); s += __shfl_xor(s, 16);
        const float rstd = __builtin_amdgcn_rsqf(s * (1.0f / 256.0f) + K::EPS);
        const size_t go = (size_t)(m0 + l) * 1024 + h * 256 + c8 * 8; const v4u rr = rrv[p];
        f32x4 a, b2;
#pragma unroll
        for (int j = 0; j < 2; ++j) { a[2 * j] = o0[2 * j] * rstd * g0[2 * j] * __uint_as_float(rr[j] << 16); a[2 * j + 1] = o0[2 * j + 1] * rstd * g0[2 * j + 1] * __uint_as_float(rr[j] & 0xffff0000u);
            b2[2 * j] = o1[2 * j] * rstd * g1[2 * j] * __uint_as_float(rr[2 + j] << 16); b2[2 * j + 1] = o1[2 * j + 1] * rstd * g1[2 * j + 1] * __uint_as_float(rr[2 + j] & 0xffff0000u); }
        *(v4u*)(OB + go) = pg8::pk8(a, b2); }
    __syncthreads();
}

__device__ __forceinline__ void logf_cumsum(const Args& A, int vcu, int wave, int G, int lane) {
    for (int s0 = wave * G + vcu; s0 < 384; s0 += NWAVES * G) {
        const bool samp = s0 >= 128; const int s = samp ? s0 - 128 : s0; const int b = s >> 4, h = s & 15;
        float* dst = samp ? (float*)(A.ws + WS_CS) + (size_t)s * K::SKR : (float*)(A.ws + WS_CP) + (size_t)s * K::SEQ;
        float v[65];
#pragma unroll
        for (int t = 0; t < 64; ++t) { const int pos = t * 64 + lane; v[t] = samp ? A.cache_lf[((size_t)b * K::PAST + pos) * 16 + h] : A.out[K::O_LFP + ((size_t)b * K::SEQ + pos) * 16 + h]; }
        v[64] = samp ? A.out[K::O_LFS + ((size_t)b * 64 + lane) * 16 + h] : 0.f;
        float carry = 0.f;
#pragma unroll
        for (int t = 0; t < 65; ++t) { if (t < 64 || samp) { float x = v[t];
#pragma unroll
                for (int o = 1; o < 64; o <<= 1) { const float y = __shfl_up(x, o); if (lane >= o) x += y; }
                x += carry; const float nk = -x * K::LOG2E; dst[t * 64 + lane] = nk; carry = __shfl(x, 63);
                const float bb = nk - __shfl(nk, 0); const unsigned bh = pg8::pkbf(bb, 0.f) & 0xffffu, bl = pg8::pkbf(bb - __uint_as_float(bh << 16), 0.f) & 0xffffu;
                ((unsigned*)((char*)dst + (7u << 20)))[t * 64 + lane] = bh | (bl << 16); } }
        if (samp) { const float last = -carry * K::LOG2E; dst[4160 + lane] = last; dst[4224 + lane] = last; dst[4288 + lane] = last; unsigned* kxp = (unsigned*)((char*)dst + (7u << 20)); kxp[4160 + lane] = 0u; kxp[4224 + lane] = 0u; kxp[4288 + lane] = 0u; }
    }
}

constexpr size_t WS_PART = WS_AO;
__device__ __forceinline__ void fixup_sample_rows(const Args& A, int wave, int aux) {
    const int lane = lane_id_(), G = gridDim.x, bx = blockIdx.x, vcu = (G % 8 == 0) ? (bx % 8) * (G / 8) + bx / 8 : bx, gw = vcu * NWAVES + wave, NGW = G * NWAVES;
    unsigned char* ws = A.ws; const float* PART = (const float*)(ws + WS_PART); bf16* HB = (bf16*)(ws + WS_HB); float* PSQ = (float*)(ws + WS_PSQ);
    for (int r = gw; r < K::MS; r += NGW) {
        const size_t m = (size_t)K::MP + r; f32x4 v[4]; float s = 0.f;
#pragma unroll
        for (int j = 0; j < 4; ++j) { const v2u hw = *((const v2u*)(HB + m * 1024) + lane + 64 * j);
            v[j][0] = __uint_as_float(hw.x << 16); v[j][1] = __uint_as_float(hw.x & 0xffff0000u); v[j][2] = __uint_as_float(hw.y << 16); v[j][3] = __uint_as_float(hw.y & 0xffff0000u); }
#pragma unroll
        for (int p = 0; p < 11; ++p)
#pragma unroll
            for (int j = 0; j < 4; ++j) v[j] = v[j] + *((const f32x4*)(PART + ((size_t)p * K::MS + r) * 1024) + lane + 64 * j);
        if (aux) {
#pragma unroll
            for (int j = 0; j < 4; ++j) { s += (v[j][0] * v[j][0] + v[j][1] * v[j][1]) + (v[j][2] * v[j][2] + v[j][3] * v[j][3]); v2u w; w.x = pg8::pkbf(v[j][0], v[j][1]); w.y = pg8::pkbf(v[j][2], v[j][3]); *((v2u*)(HB + m * 1024) + lane + 64 * j) = w; }
            s = wave_sum(s);
            if (lane < 16) PSQ[m * 16 + lane] = (lane == 0) ? s : 0.f;
        } else {
#pragma unroll
            for (int j = 0; j < 4; ++j) *((f32x4*)(A.out + m * 1024) + lane + 64 * j) = v[j];
        }
    }
}

#define XB_TMO      128
#define XB_XCNT(j)  (256  + 64 * (j))
#define XB_XSUB(j)  (1280 + 64 * (j))
#define XB_XGEN(j)  (2304 + 64 * (j))
#define XB_TOP      3328
#define XB_TOPGEN   3392
#define XCD_BAR_WORDS 3456
#define XB_SPIN_CAP (1u << 18)

__device__ __forceinline__ unsigned xb_ld(unsigned* p)              { return __hip_atomic_load(p, __ATOMIC_RELAXED, __HIP_MEMORY_SCOPE_AGENT); }
__device__ __forceinline__ unsigned xb_add(unsigned* p, unsigned v) { return __hip_atomic_fetch_add(p, v, __ATOMIC_RELAXED, __HIP_MEMORY_SCOPE_AGENT); }
__device__ __forceinline__ unsigned xb_xcc_id() { return (unsigned)__builtin_amdgcn_s_getreg((3 << 11) | 20) & 0xFu; }
#define XB_SPIN(cond, bar) do { unsigned _sp = 0; while (cond) { __builtin_amdgcn_s_sleep(1); \
    if ((++_sp & 255u) == 0u) { if (xb_ld(&(bar)[XB_TMO])) break; if (_sp > XB_SPIN_CAP) { atomicAdd(&(bar)[XB_TMO], 1u); break; } } } } while (0)

struct XcdBarrier {
    unsigned* bar; unsigned x;
    volatile LAS unsigned* st;
};

__device__ __forceinline__ XcdBarrier xcd_barrier_post(unsigned* bar, volatile LAS unsigned* st) {
    XcdBarrier b; b.bar = bar; b.x = xb_xcc_id(); b.st = st;
    if (threadIdx.x == 0) (void)xb_add(&bar[XB_XCNT(b.x)], 1u);
    return b;
}
__device__ __forceinline__ void xcd_barrier_complete(unsigned* bar, unsigned x, unsigned& nloc, unsigned& nx) {
    const unsigned G = gridDim.x * gridDim.y * gridDim.z;
    unsigned sum, cnt, mine, sp = 0u;
    for (;;) {
        sum = 0u; cnt = 0u; mine = 0u;
#pragma unroll
        for (unsigned j = 0; j < 16; ++j) { const unsigned c = xb_ld(&bar[XB_XCNT(j)]); sum += c; cnt += (c > 0u) ? 1u : 0u; mine = (j == x) ? c : mine; }
        if (sum == G) break;
        __builtin_amdgcn_s_sleep(1);
        if ((++sp & 255u) == 0u) { if (xb_ld(&bar[XB_TMO])) break; if (sp > XB_SPIN_CAP) { atomicAdd(&bar[XB_TMO], 1u); break; } }
    }
    nloc = mine > 0u ? mine : 1u; nx = cnt > 0u ? cnt : 1u;
}

__device__ __forceinline__ void xcd_barrier(const XcdBarrier& b, const int wv) {
    const bool leader_ = (wv == 0) && (lane_id_() == 0);
    asm volatile("s_waitcnt vmcnt(0)" ::: "memory");
    __syncthreads();
    if (leader_) {
        unsigned* bar = b.bar;
        __builtin_amdgcn_s_waitcnt(0);
        unsigned nloc = b.st[0], nx = b.st[1];
        if (nloc == 0u) { xcd_barrier_complete(bar, b.x, nloc, nx); b.st[0] = nloc; b.st[1] = nx; }
        const unsigned old = xb_add(&bar[XB_XSUB(b.x)], 1u);
        const unsigned gen = old / nloc;
        if (old + 1u == (gen + 1u) * nloc) {
            __builtin_amdgcn_fence(__ATOMIC_RELEASE, "agent");
            asm volatile("s_waitcnt vmcnt(0)" ::: "memory");
            const unsigned og = xb_add(&bar[XB_TOP], 1u);
            const unsigned tg = og / nx;
            if (og + 1u == (tg + 1u) * nx) xb_add(&bar[XB_TOPGEN], 1u);
            else XB_SPIN(xb_ld(&bar[XB_TOPGEN]) == tg, bar);
            __builtin_amdgcn_fence(__ATOMIC_ACQUIRE, "agent");
            xb_add(&bar[XB_XGEN(b.x)], 1u);
            asm volatile("s_waitcnt vmcnt(0)" ::: "memory");
        } else {
            XB_SPIN(xb_ld(&bar[XB_XGEN(b.x)]) == gen, bar);
            __builtin_amdgcn_fence(__ATOMIC_ACQUIRE, "agent");
            asm volatile("s_waitcnt vmcnt(0)" ::: "memory");
        }
    }
    __syncthreads();
}

__device__ __forceinline__ void stagger_start(bool late, unsigned ticks  ) {
    if (late) { const unsigned long long t0 = __builtin_amdgcn_s_memrealtime(); while (__builtin_amdgcn_s_memrealtime() - t0 < ticks) __builtin_amdgcn_s_sleep(64); }
}
__device__ __forceinline__ bool opaque_true() { int one = 1; asm volatile("" : "+s"(one)); return one != 0; }
__device__ __forceinline__ Args load_args() {
    typedef const __attribute__((address_space(4))) unsigned long long* KP;
    KP kp = (KP)__builtin_amdgcn_kernarg_segment_ptr(); asm volatile("" : "+s"(kp));
    Args a;
    a.x_p = (const float*)(const GAS float*)kp[0]; a.x_s = (const float*)(const GAS float*)kp[1]; a.state = (const float*)(const GAS float*)kp[2]; a.cache_k = (const float*)(const GAS float*)kp[3]; a.cache_v = (const float*)(const GAS float*)kp[4]; a.cache_lf = (const float*)(const GAS float*)kp[5];
    a.ffn_norm = (const float*)(const GAS float*)kp[6]; a.w_gu = (const float*)(const GAS float*)kp[7]; a.w_dn = (const float*)(const GAS float*)kp[8]; a.mix_norm = (const float*)(const GAS float*)kp[9]; a.a_w_in = (const float*)(const GAS float*)kp[10]; a.a_w_g2 = (const float*)(const GAS float*)kp[11];
    a.a_b_g = (const float*)(const GAS float*)kp[12]; a.a_g_out = (const float*)(const GAS float*)kp[13]; a.a_w_o = (const float*)(const GAS float*)kp[14]; a.kv_norm = (const float*)(const GAS float*)kp[15]; a.w_kvf = (const float*)(const GAS float*)kp[16]; a.b_f = (const float*)(const GAS float*)kp[17];
    a.g_k = (const float*)(const GAS float*)kp[18]; a.b_w_qg = (const float*)(const GAS float*)kp[19]; a.b_g_q = (const float*)(const GAS float*)kp[20]; a.b_w_o = (const float*)(const GAS float*)kp[21]; a.out = (float*)(GAS float*)kp[22]; a.ws = (unsigned char*)(GAS unsigned char*)kp[23];
    return a;
}
__global__ void __launch_bounds__(NTHREADS, 2) mega_fwd(Args A_) {
    extern __shared__ __attribute__((aligned(16))) unsigned char lds_raw[];
    LAS unsigned char* lds = (LAS unsigned char*)lds_raw;
    cg::grid_group grid = cg::this_grid();
    const int wave = __builtin_amdgcn_readfirstlane((int)threadIdx.x >> 6);
#define PH_LOCALS const Args A = load_args(); const int lane = lane_id_(), tid = wave * 64 + lane; (void)tid; const int G = gridDim.x, bx = blockIdx.x; const int vcu = (G % 8 == 0) ? (bx % 8) * (G / 8) + bx / 8 : bx; \
        const int gw = vcu * NWAVES + wave, NGW = G * NWAVES; (void)gw; (void)NGW; const XcdBarrier xbar{(unsigned*)A.ws + 4096, xb_xcc_id(), (volatile LAS unsigned*)(lds + 147200) + 8}; (void)xbar; unsigned char* ws = A.ws; asm volatile("" : "+s"(ws)); float* H = A.out; asm volatile("" : "+s"(H)); \
        bf16* HB = (bf16*)(ws + WS_HB); float* PSQ = (float*)(ws + WS_PSQ); bf16* ACT = (bf16*)(ws + WS_ACT); (void)HB; (void)PSQ; (void)ACT; (void)H;
    volatile LAS unsigned* MISC = (volatile LAS unsigned*)(lds + 147200);
    if (threadIdx.x < 32) MISC[threadIdx.x] = 0u;
    __syncthreads();
    (void)xcd_barrier_post((unsigned*)A_.ws + 4096, MISC + 8);
#ifndef PH_MASK
#define PH_MASK 0xffff
#endif
#define IN(k) ((((PH_MASK >> (k)) & 1) != 0) && opaque_true())
#define SEAM(k) do { if ((((PH_MASK >> (k)) & 3) == 3)) { if ((k) == 0 && !opaque_true()) grid.sync();     \
        { const XcdBarrier xb_{(unsigned*)load_args().ws + 4096, xb_xcc_id(), (volatile LAS unsigned*)(lds + 147200) + 8}; xcd_barrier(xb_, wave); } } } while (0)
#define GEMM_SW(Bt_off, Nn, cjslot) do { pg8::Gemm g{HB, (const pg8::bf16_t*)(ws + (Bt_off)), K::M, (Nn), 1024, 1024}; pg8::StaticOrder S; S.init(K::M, (Nn), G, bx); pg8::EpiSwiGLU E{ACT, PSQ, pg8::CacheJob{A.cache_k, A.cache_v, (bf16*)(ws + WS_KS), (bf16*)(ws + WS_VS), (cjslot)}}; \
        pg8::gemm_phase<pg8::EpiSwiGLU, pg8::StaticOrder, true, true>(lds, g, S, E, wave); } while (0)
#define GEMM_DN(mi, youtp) do { { pg8::Gemm g{ACT, (const pg8::bf16_t*)(ws + WS_WDN + (mi) * WDN_BYTES), K::MP, 1024, K::FF, K::FF}; pg8::StaticOrder S; S.init(K::MP, 1024, G, bx); \
        pg8::EpiResid E{HB, PSQ, 0.5f, (youtp)}; pg8::gemm_phase<pg8::EpiResid, pg8::StaticOrder, true, true>(lds, g, S, E, wave); } \
      { pg8::Gemm g{ACT, (const pg8::bf16_t*)(ws + WS_WDN + (mi) * WDN_BYTES), K::M, 1024, 256, K::FF}; pg8::SliceOrder S; S.init(K::MP / 256, 4, 4, 11, G, bx); \
        pg8::EpiPartial E{(float*)(ws + WS_PART), 0.5f}; pg8::gemm_phase<pg8::EpiPartial, pg8::SliceOrder, true, true>(lds, g, S, E, wave); } } while (0)
#define FIXUP(auxv) do { fixup_sample_rows(A, wave, (auxv)); xcd_barrier(xbar, wave); } while (0)

    if (IN(0)) { PH_LOCALS p0_prologue(A, lds, gw, NGW, lane, wave); }
    SEAM(0);
    if (IN(1)) { PH_LOCALS GEMM_SW(WS_WGU00, K::NGU, 0); }
    SEAM(1);
    if (IN(2)) { PH_LOCALS GEMM_DN(0, (float*)nullptr); }
    SEAM(2);
    if (IN(3)) { PH_LOCALS FIXUP(1); pg8::Gemm g{HB, (const pg8::bf16_t*)(ws + WS_WIN), K::M, K::NIN, 1024, 1024}; pg8::StaticOrder S; S.init(K::M, K::NIN, G, bx);
        pg8::EpiInProj E{(bf16*)(ws + WS_GQ), (bf16*)(ws + WS_GK), (bf16*)(ws + WS_GV), (bf16*)(ws + WS_GR), (float*)(ws + WS_GL), PSQ};
        pg8::gemm_phase<pg8::EpiInProj, pg8::StaticOrder, true, true>(lds, g, S, E, wave); }
    SEAM(3);
    if (IN(4)) { PH_LOCALS
        for (int it = vcu; it < 2112; it += G) gla_prep_item(A, lds, it, tid);
        xcd_barrier(xbar, wave);
        for (int it = vcu; it < 256; it += G) gla_scan_item<64>(A, it >> 5, (it >> 3) & 3, it & 7, tid);
        for (int it = vcu; it < 512; it += G) gla_scan_item<1>(A, it >> 5, (it >> 3) & 3, it & 7, tid);
    }
    SEAM(4);
    if (IN(5)) { PH_LOCALS { const int w_ = wave, fr_ = lane & 15, fq_ = lane >> 4; OutB Bc; if (vcu < 2112) gla_out_loadB(Bc, ws, vcu, w_, fr_, fq_); for (int it = vcu; it < 2112; it += G) gla_out_item(A, lds, it, tid, Bc, it + G); } }
    SEAM(5);
    if (IN(6)) { PH_LOCALS pg8::Gemm g{(const pg8::bf16_t*)(ws + WS_OB), (const pg8::bf16_t*)(ws + WS_WOA), K::M, 1024, 1024, 1024}; pg8::StaticOrder S; S.init(K::M, 1024, G, bx);
        pg8::EpiResid E{HB, PSQ, 1.0f, (float*)nullptr}; pg8::gemm_phase<pg8::EpiResid, pg8::StaticOrder, true, true>(lds, g, S, E, wave); }
    SEAM(6);
    if (IN(7)) { PH_LOCALS GEMM_SW(WS_WGU01, K::NGU, 1); }
    SEAM(7);
    if (IN(8)) { PH_LOCALS GEMM_DN(1, (float*)nullptr); }
    SEAM(8);
    if (IN(9)) { PH_LOCALS FIXUP(1); pg8::Gemm g{HB, (const pg8::bf16_t*)(ws + WS_WKVF), K::M, K::NCAT, 1024, 1024}; pg8::StaticOrder S; S.init(K::M, K::NCAT, G, bx);
        pg8::EpiCat E{A.out, (bf16*)(ws + WS_KP), (bf16*)(ws + WS_VP), (bf16*)(ws + WS_KS), (bf16*)(ws + WS_VS), A.g_k, A.b_f, PSQ, ACT, pg8::CacheJob{A.cache_k, A.cache_v, (bf16*)(ws + WS_KS), (bf16*)(ws + WS_VS), 2}};
        pg8::gemm_phase<pg8::EpiCat, pg8::StaticOrder, true, true>(lds, g, S, E, wave); }
    SEAM(9);
    if (IN(10)) { PH_LOCALS logf_cumsum(A, vcu, wave, G, lane); GEMM_DN(2, (float*)nullptr); }
    SEAM(10);
    if (IN(11)) { PH_LOCALS FIXUP(1); pg8::Gemm g{HB, (const pg8::bf16_t*)(ws + WS_WQG), K::M, K::NQG, 1024, 1024}; pg8::StaticOrder S; S.init(K::M, K::NQG, G, bx);
        pg8::EpiQG E{(bf16*)(ws + WS_QP), (bf16*)(ws + WS_GATE), A.b_g_q, PSQ};
        pg8::gemm_phase<pg8::EpiQG, pg8::StaticOrder, true, true>(lds, g, S, E, wave); }
    SEAM(11);
    if (IN(12)) { PH_LOCALS
        typedef attn_body::bf16 abf; char* shm = (char*)lds_raw;
        for (int v = vcu; v < 256; v += G) {
            for (int i = 0; i < 9; ++i) {
                unsigned char* wl = ws; asm volatile("" : "+s"(wl));
                const abf *Qu, *Kh, *Vh; const float* cn; int nt; unsigned stm;
                if (i < 8) { const int bh = v >> 1, b = bh >> 4, h = bh & 15; const int s = 4 * (v & 1) + (i >> 1); const int qb = (i & 1) ? 15 - s : s;
                    const size_t r0 = (size_t)b * K::SEQ + qb * 256, ro = r0 * 1024 + h * 64, kb0 = (size_t)b * K::SEQ * 1024 + h * 64;
                    Qu = (const abf*)(wl + WS_QP) + ro; Kh = (const abf*)(wl + WS_KP) + kb0; Vh = (const abf*)(wl + WS_VP) + kb0; cn = (const float*)(wl + WS_CP) + (size_t)bh * K::SEQ; nt = 4 * (qb + 1); stm = 0xffu; }
                else { const int sb = v >> 4, sh = v & 15;
                    const size_t ro = ((size_t)K::MP + sb * 64) * 1024 + sh * 64, kb0 = (size_t)sb * K::SKR * 1024 + sh * 64;
                    Qu = (const abf*)(wl + WS_QP) + ro; Kh = (const abf*)(wl + WS_KS) + kb0; Vh = (const abf*)(wl + WS_VS) + kb0; cn = (const float*)(wl + WS_CS) + (size_t)(sb * 16 + sh) * K::SKR; nt = 68; stm = 0x3u; }
                attn_body::attn_unit<8>(Qu, Kh, Vh, (long)((WS_AO - WS_QP) / 2), (long)((WS_GATE - WS_QP) / 2), cn, nt, stm, shm, wave);
            }
        }
    }
    SEAM(12);
    if (IN(13)) { PH_LOCALS pg8::Gemm g{(const pg8::bf16_t*)(ws + WS_AO), (const pg8::bf16_t*)(ws + WS_WOB), K::M, 1024, 1024, 1024}; pg8::StaticOrder S; S.init(K::M, 1024, G, bx);
        pg8::EpiResid E{HB, PSQ, 1.0f, (float*)nullptr}; pg8::gemm_phase<pg8::EpiResid, pg8::StaticOrder, true, true>(lds, g, S, E, wave); }
    SEAM(13);
    if (IN(14)) { PH_LOCALS GEMM_SW(WS_WGU11, K::NGU, -1); }
    SEAM(14);
    if (IN(15)) { PH_LOCALS GEMM_DN(3, H); xcd_barrier(xbar, wave); fixup_sample_rows(A, wave, 0); }
#undef IN
#undef SEAM
}

#ifndef MK_MULTI
#define MK_MULTI 0
#endif
extern "C" void kernel_launch(void* const* d_in, const int* in_sizes, int n_in, void* d_out, int out_size, void* d_ws, size_t ws_size, hipStream_t stream) {
    static int grid = 0;
    if (grid == 0) {
        if (n_in != 22 || (size_t)out_size != K::O_TOTAL || ws_size < WS_END) { fprintf(stderr, "kernel_launch: unexpected shapes (n_in %d out %d ws %zu)\n", n_in, out_size, ws_size); grid = -1; return; }
        int dev = 0, cus = 0, per_cu = 0;
        hipGetDevice(&dev); hipDeviceGetAttribute(&cus, hipDeviceAttributeMultiprocessorCount, dev);
        if (hipFuncSetAttribute((const void*)mega_fwd, hipFuncAttributeMaxDynamicSharedMemorySize, LDS_BYTES) != hipSuccess) { fprintf(stderr, "hipFuncSetAttribute failed\n"); grid = -1; return; }
        if (hipOccupancyMaxActiveBlocksPerMultiprocessor(&per_cu, (const void*)mega_fwd, NTHREADS, LDS_BYTES) != hipSuccess || per_cu < 1) { fprintf(stderr, "occupancy query: %d\n", per_cu); per_cu = 1; }
        (void)hipGetLastError();
        grid = cus * 1;
        if (grid > 256) grid = 256;
    }
    if (grid < 0) return;
    if (hipMemsetAsync(d_ws, 0, 1u << 20, stream) != hipSuccess) { fprintf(stderr, "memset failed\n"); return; }
    Args a{};
    const float** p = (const float**)&a;
    for (int i = 0; i < 22; ++i) p[i] = (const float*)d_in[i];
    a.out = (float*)d_out; a.ws = (unsigned char*)d_ws;
    void* args[] = {&a};
    hipError_t e = hipLaunchCooperativeKernel((const void*)mega_fwd, dim3(grid), dim3(NTHREADS), args, LDS_BYTES, stream);
    if (e != hipSuccess) fprintf(stderr, "cooperative launch failed: %s (grid %d)\n", hipGetErrorString(e), grid);
}
```
